# Optimizing an MI355X kernel written in HIP

```python
import jax, jax.numpy as jnp
from jax import lax
import numpy as np

D_MODEL = 1024
BATCH = 4
SEQ = 4096
DEPTH = 4

RET_HEADS = 4
RET_DK = 128
RET_DV = 128
FOX_HEADS = 8
FOX_DH = 64
D_FF = 2816
CHUNK = 128
Q_BLOCK = 128
ROPE_BASE = 10000.0
EPS = 1e-6

RET_QK = RET_HEADS * RET_DK
RET_V = RET_HEADS * RET_DV
FOX_W = FOX_HEADS * FOX_DH
IN_SPLITS = (RET_QK, RET_QK, RET_V, RET_V, FOX_W, FOX_W, FOX_W, FOX_HEADS, D_MODEL, D_MODEL)
IN_COLS = sum(IN_SPLITS)

kernel_name = "hybrid_retention_forgetting_attention_macaron"


def rmsnorm(x, g):
    xf = x.astype(jnp.float32)
    y = xf * lax.rsqrt(jnp.mean(xf * xf, axis=-1, keepdims=True) + EPS)
    return (y * g.astype(jnp.float32)).astype(x.dtype)


def swiglu(h, w_in, w_out):
    gu = h @ w_in
    a, b = gu[..., :D_FF], gu[..., D_FF:]
    return (jax.nn.silu(a) * b) @ w_out


def split_cols(p):
    outs = []
    off = 0
    for w in IN_SPLITS:
        outs.append(p[..., off:off + w])
        off += w
    return outs


def to_heads(t, n_heads):
    b, s, _ = t.shape
    return t.reshape(b, s, n_heads, -1).transpose(0, 2, 1, 3)


def from_heads(t):
    b, h, s, d = t.shape
    return t.transpose(0, 2, 1, 3).reshape(b, s, h * d)


def rope(t):
    s, d = t.shape[2], t.shape[3]
    inv = jnp.power(ROPE_BASE, -jnp.arange(0, d, 2, dtype=jnp.float32) / d)
    ang = jnp.arange(s, dtype=jnp.float32)[:, None] * inv[None, :]
    cos, sin = jnp.cos(ang), jnp.sin(ang)
    tf = t.astype(jnp.float32)
    t1, t2 = tf[..., : d // 2], tf[..., d // 2:]
    return jnp.concatenate([t1 * cos - t2 * sin, t1 * sin + t2 * cos], axis=-1).astype(t.dtype)


def retention_chunkwise(q, k, v):
    in_dtype = v.dtype
    q = q.astype(jnp.float32)
    k = k.astype(jnp.float32) * (q.shape[-1] ** -0.5)
    v = v.astype(jnp.float32)
    b, h, s, dk = q.shape
    dv = v.shape[-1]
    n = s // CHUNK
    log_gamma = jnp.log1p(-jnp.exp2(-5.0 - jnp.arange(h, dtype=jnp.float32)))
    idx = jnp.arange(CHUNK, dtype=jnp.float32)
    diff = idx[:, None] - idx[None, :]
    decay_intra = jnp.where(diff >= 0, jnp.exp(log_gamma[:, None, None] * jnp.maximum(diff, 0.0)), 0.0)
    xi = jnp.exp(log_gamma[:, None] * (idx + 1.0))
    zeta = jnp.exp(log_gamma[:, None] * (CHUNK - 1.0 - idx))
    gamma_c = jnp.exp(log_gamma * CHUNK)

    qc = q.reshape(b, h, n, CHUNK, dk)
    kc = k.reshape(b, h, n, CHUNK, dk)
    vc = v.reshape(b, h, n, CHUNK, dv)

    scores = jnp.einsum('bhncd,bhnsd->bhncs', qc, kc) * decay_intra[None, :, None]
    inner = jnp.einsum('bhncs,bhnse->bhnce', scores, vc)

    kv = jnp.einsum('bhncd,bhnce->bhnde', kc * zeta[None, :, None, :, None], vc)

    def step(state, kv_n):
        return gamma_c[None, :, None, None] * state + kv_n, state

    _, state_prev = lax.scan(step, jnp.zeros((b, h, dk, dv), jnp.float32), jnp.moveaxis(kv, 2, 0))
    state_prev = jnp.moveaxis(state_prev, 0, 2)
    cross = jnp.einsum('bhncd,bhnde->bhnce', qc * xi[None, :, None, :, None], state_prev)
    return (inner + cross).reshape(b, h, s, dv).astype(in_dtype)


def forgetting_attention(q, k, v, log_f):
    b, h, s, d = q.shape
    c = jnp.cumsum(log_f, axis=-1)
    kpos = jnp.arange(s)
    scale = d ** -0.5
    n_blocks = s // Q_BLOCK

    def block(i):
        start = i * Q_BLOCK
        qb = lax.dynamic_slice_in_dim(q, start, Q_BLOCK, axis=2)
        cb = lax.dynamic_slice_in_dim(c, start, Q_BLOCK, axis=2)
        qpos = start + jnp.arange(Q_BLOCK)
        logits = jnp.einsum('bhqd,bhkd->bhqk', qb, k).astype(jnp.float32) * scale
        logits = logits + (cb[..., :, None] - c[..., None, :])
        logits = jnp.where(kpos[None, :] <= qpos[:, None], logits, -1e30)
        p = jax.nn.softmax(logits, axis=-1)
        return jnp.einsum('bhqk,bhkd->bhqd', p.astype(v.dtype), v)

    out = lax.map(block, jnp.arange(n_blocks))
    return jnp.moveaxis(out, 0, 2).reshape(b, h, s, d)


def mixing_sublayer(h, w_in, b_forget, ret_norm, w_o_ret, w_o_fox, w_out):
    proj = h @ w_in
    rq, rk, rv, rg, fq, fk, fv, ff, gate_r, gate_f = split_cols(proj)

    ret = retention_chunkwise(rope(to_heads(rq, RET_HEADS)), rope(to_heads(rk, RET_HEADS)), to_heads(rv, RET_HEADS))
    retf = ret.astype(jnp.float32)
    retf = retf * lax.rsqrt(jnp.mean(retf * retf, axis=-1, keepdims=True) + EPS)
    ret = from_heads(retf.astype(h.dtype)) * ret_norm
    y_ret = (jax.nn.silu(rg) * ret) @ w_o_ret

    log_f = jax.nn.log_sigmoid((ff + b_forget).astype(jnp.float32))
    fox = forgetting_attention(to_heads(fq, FOX_HEADS), to_heads(fk, FOX_HEADS), to_heads(fv, FOX_HEADS),
                               log_f.transpose(0, 2, 1))
    y_fox = from_heads(fox) @ w_o_fox

    merged = jax.nn.sigmoid(gate_r) * y_ret + jax.nn.sigmoid(gate_f) * y_fox
    return merged @ w_out


def setup_inputs(seed: int = 0) -> dict:
    key = jax.random.key(seed)
    ks = jax.random.split(key, 16)
    f32 = jnp.float32

    def nrm(k, shape, fan_in):
        return jax.random.normal(k, shape, f32) * (fan_in ** -0.5)

    def gain(k, shape):
        return 1.0 + 0.02 * jax.random.normal(k, shape, f32)

    return {
        "x": jax.random.normal(ks[0], (BATCH, SEQ, D_MODEL), f32),
        "norm_ffn1": gain(ks[1], (DEPTH, D_MODEL)),
        "w_ffn1_in": nrm(ks[2], (DEPTH, D_MODEL, 2 * D_FF), D_MODEL),
        "w_ffn1_out": nrm(ks[3], (DEPTH, D_FF, D_MODEL), D_FF),
        "norm_mix": gain(ks[4], (DEPTH, D_MODEL)),
        "w_in": nrm(ks[5], (DEPTH, D_MODEL, IN_COLS), D_MODEL),
        "b_forget": jax.random.uniform(ks[6], (DEPTH, FOX_HEADS), f32, minval=1.0, maxval=4.0),
        "ret_norm": gain(ks[7], (DEPTH, RET_V)),
        "w_o_ret": nrm(ks[8], (DEPTH, RET_V, D_MODEL), RET_V),
        "w_o_fox": nrm(ks[9], (DEPTH, FOX_W, D_MODEL), FOX_W),
        "w_out": nrm(ks[10], (DEPTH, D_MODEL, D_MODEL), D_MODEL),
        "norm_ffn2": gain(ks[11], (DEPTH, D_MODEL)),
        "w_ffn2_in": nrm(ks[12], (DEPTH, D_MODEL, 2 * D_FF), D_MODEL),
        "w_ffn2_out": nrm(ks[13], (DEPTH, D_FF, D_MODEL), D_FF),
        "norm_final": gain(ks[14], (D_MODEL,)),
    }


def reference(x, norm_ffn1, w_ffn1_in, w_ffn1_out, norm_mix, w_in, b_forget, ret_norm,
              w_o_ret, w_o_fox, w_out, norm_ffn2, w_ffn2_in, w_ffn2_out, norm_final):
    for l in range(DEPTH):
        x = x + 0.5 * swiglu(rmsnorm(x, norm_ffn1[l]), w_ffn1_in[l], w_ffn1_out[l])
        h = rmsnorm(x, norm_mix[l])
        x = x + mixing_sublayer(h, w_in[l], b_forget[l], ret_norm[l], w_o_ret[l], w_o_fox[l], w_out[l])
        x = x + 0.5 * swiglu(rmsnorm(x, norm_ffn2[l]), w_ffn2_in[l], w_ffn2_out[l])
    return rmsnorm(x, norm_final)
```

```cpp
#include <hip/hip_runtime.h>
#include <cstdio>
#include <cstdint>

typedef unsigned short bf16_t;

constexpr int D = 1024, BATCH = 4, SEQ = 4096, DEPTH = 4, M = BATCH * SEQ;
constexpr int RH = 4, RDK = 128, FH = 8, FD = 64, DFF = 2816, IN_COLS = 5640;
constexpr float EPS = 1e-6f;
constexpr int C_RQ = 0, C_RK = 512, C_RV = 1024, C_RG = 1536, C_FQ = 2048, C_FK = 2560, C_FV = 3072, C_FF = 3584, C_GR = 3592, C_GF = 4616;

constexpr size_t MiB = 1u << 20;
constexpr size_t WS_CTL = 0, CTL_BYTES = 2 * MiB;
constexpr size_t WS_ROWSS = 1 * MiB;
constexpr size_t WS_COS = 2 * MiB, WS_SIN = 3 * MiB;
constexpr size_t WS_LFT = 4 * MiB;
constexpr size_t WS_CUM = 4 * MiB + 512 * 1024;
constexpr size_t WS_XB = 8 * MiB;
constexpr size_t WS_QR = 40 * MiB, WS_KR = 56 * MiB, WS_VR = 72 * MiB, WS_GR = 88 * MiB, WS_FQ = 104 * MiB, WS_FK = 120 * MiB, WS_FV = 136 * MiB;
constexpr size_t WS_GATER = 152 * MiB, WS_GATEF = 184 * MiB;
constexpr size_t WS_H = 40 * MiB;
constexpr size_t WS_MERGED = 56 * MiB;
constexpr size_t WS_END = 216 * MiB;

__device__ __forceinline__ float bf2f(bf16_t v) { return __uint_as_float((unsigned)v << 16); }
__device__ __forceinline__ bf16_t f2bf(float f) { unsigned u = __float_as_uint(f); return (bf16_t)((u + 0x7fffu + ((u >> 16) & 1u)) >> 16); }
__device__ __forceinline__ float silu_f(float v) { return v / (1.f + __expf(-v)); }
__device__ __forceinline__ float sigmoid_f(float v) { return 1.f / (1.f + __expf(-v)); }
__device__ __forceinline__ float logsigmoid_f(float z) { return z >= 0.f ? -log1pf(expf(-z)) : z - log1pf(expf(z)); }
__device__ __forceinline__ float wave_sum(float v) {
#pragma unroll
    for (int o = 1; o < 64; o <<= 1) v += __shfl_xor(v, o);
    return v;
}

__global__ void k_rope_table(float* cs, float* sn) {
    const int idx = blockIdx.x * blockDim.x + threadIdx.x;
    if (idx >= SEQ * 64) return;
    const int s = idx / 64, i = idx % 64;
    const double inv = pow(10000.0, -(double)(2 * i) / 128.0);
    const double a = (double)s * inv;
    cs[idx] = (float)cos(a); sn[idx] = (float)sin(a);
}

__global__ __launch_bounds__(256) void k_rownorm(const float* x, bf16_t* xb, float* rowss) {
    const int row = blockIdx.x * 4 + (threadIdx.x >> 6), lane = threadIdx.x & 63;
    const float4* xr = (const float4*)(x + (size_t)row * D) + lane;
    float s = 0.f;
#pragma unroll
    for (int j = 0; j < 4; ++j) {
        const float4 v = xr[64 * j];
        s += v.x * v.x + v.y * v.y + v.z * v.z + v.w * v.w;
        ushort4 o; o.x = f2bf(v.x); o.y = f2bf(v.y); o.z = f2bf(v.z); o.w = f2bf(v.w);
        ((ushort4*)(xb + (size_t)row * D))[lane + 64 * j] = o;
    }
    s = wave_sum(s);
    if (lane == 0) rowss[row] = s;
}

__global__ __launch_bounds__(256) void k_final_norm(float* x, const float* g) {
    const int row = blockIdx.x * 4 + (threadIdx.x >> 6), lane = threadIdx.x & 63;
    float4* xr = (float4*)(x + (size_t)row * D) + lane;
    float4 v[4]; float s = 0.f;
#pragma unroll
    for (int j = 0; j < 4; ++j) { v[j] = xr[64 * j]; s += v[j].x * v[j].x + v[j].y * v[j].y + v[j].z * v[j].z + v[j].w * v[j].w; }
    const float rstd = rsqrtf(wave_sum(s) * (1.f / D) + EPS);
#pragma unroll
    for (int j = 0; j < 4; ++j) {
        const float4 gg = ((const float4*)g)[lane + 64 * j];
        float4 o; o.x = v[j].x * rstd * gg.x; o.y = v[j].y * rstd * gg.y; o.z = v[j].z * rstd * gg.z; o.w = v[j].w * rstd * gg.w;
        xr[64 * j] = o;
    }
}

template <class Epi, bool DUAL>
__global__ __launch_bounds__(256) void k_slow_gemm(const bf16_t* A1, int lda1, const bf16_t* A2, int lda2, const float* W1, int ldw1, const float* W2, int ldw2,
                                                   const float* gain, int N, int K, Epi epi) {
    __shared__ float As1[16][68], Ws1[16][68], As2[16][68], Ws2[16][68];
    const int tid = threadIdx.x, tx = tid & 15, ty = tid >> 4;
    const int m0 = blockIdx.y * 64, n0 = blockIdx.x * 64;
    float acc1[4][4], acc2[4][4];
#pragma unroll
    for (int i = 0; i < 4; ++i)
#pragma unroll
        for (int j = 0; j < 4; ++j) { acc1[i][j] = 0.f; acc2[i][j] = 0.f; }
    const int ar = tid >> 2, ak = (tid & 3) * 4;
    const int wk = tid >> 4, wn = (tid & 15) * 4;
    for (int k0 = 0; k0 < K; k0 += 16) {
        {
            const bf16_t* p = A1 + (size_t)(m0 + ar) * lda1 + k0 + ak;
#pragma unroll
            for (int j = 0; j < 4; ++j) As1[ak + j][ar] = bf2f(p[j]);
            const float g = gain ? gain[k0 + wk] : 1.f;
#pragma unroll
            for (int j = 0; j < 4; ++j) Ws1[wk][wn + j] = (n0 + wn + j < N) ? W1[(size_t)(k0 + wk) * ldw1 + n0 + wn + j] * g : 0.f;
            if (DUAL) {
                const bf16_t* p2 = A2 + (size_t)(m0 + ar) * lda2 + k0 + ak;
#pragma unroll
                for (int j = 0; j < 4; ++j) As2[ak + j][ar] = bf2f(p2[j]);
#pragma unroll
                for (int j = 0; j < 4; ++j) Ws2[wk][wn + j] = (n0 + wn + j < N) ? W2[(size_t)(k0 + wk) * ldw2 + n0 + wn + j] * g : 0.f;
            }
        }
        __syncthreads();
#pragma unroll
        for (int kk = 0; kk < 16; ++kk) {
            float a[4], w[4];
#pragma unroll
            for (int i = 0; i < 4; ++i) a[i] = As1[kk][ty * 4 + i];
#pragma unroll
            for (int j = 0; j < 4; ++j) w[j] = Ws1[kk][tx * 4 + j];
#pragma unroll
            for (int i = 0; i < 4; ++i)
#pragma unroll
                for (int j = 0; j < 4; ++j) acc1[i][j] += a[i] * w[j];
            if (DUAL) {
#pragma unroll
                for (int i = 0; i < 4; ++i) a[i] = As2[kk][ty * 4 + i];
#pragma unroll
                for (int j = 0; j < 4; ++j) w[j] = Ws2[kk][tx * 4 + j];
#pragma unroll
                for (int i = 0; i < 4; ++i)
#pragma unroll
                    for (int j = 0; j < 4; ++j) acc2[i][j] += a[i] * w[j];
            }
        }
        __syncthreads();
    }
#pragma unroll
    for (int i = 0; i < 4; ++i)
#pragma unroll
        for (int j = 0; j < 4; ++j) { const int n = n0 + tx * 4 + j; if (n < N) epi(m0 + ty * 4 + i, n, acc1[i][j], acc2[i][j]); }
}

struct RowScale { const float* rowss; __device__ __forceinline__ float operator()(int m) const { return rsqrtf(rowss[m] * (1.f / D) + EPS); } };
struct EpSwiglu { RowScale rs; bf16_t* H; __device__ void operator()(int m, int n, float a, float b) const { const float r = rs(m); H[(size_t)m * DFF + n] = f2bf(silu_f(a * r) * (b * r)); } };
struct EpResid { float* x; float alpha; __device__ void operator()(int m, int n, float a, float) const { x[(size_t)m * D + n] += alpha * a; } };
struct EpRope { RowScale rs; const float* cs; const float* sn; bf16_t* dst; int head; float scale;
    __device__ void operator()(int m, int n, float a, float b) const { const float r = rs(m) * scale; a *= r; b *= r; const int s = m % SEQ; const float c = cs[s * 64 + n], si = sn[s * 64 + n];
        dst[(size_t)m * 512 + head * 128 + n] = f2bf(a * c - b * si); dst[(size_t)m * 512 + head * 128 + 64 + n] = f2bf(a * si + b * c); } };
struct EpStore { RowScale rs; bf16_t* dst; int ldd; int act; float scale;
    __device__ void operator()(int m, int n, float a, float) const { float v = a * rs(m); v = act == 1 ? silu_f(v) : act == 2 ? sigmoid_f(v) : v; dst[(size_t)m * ldd + n] = f2bf(v * scale); } };
struct EpForget { RowScale rs; const float* bias; float* lft;
    __device__ void operator()(int m, int n, float a, float) const { const int b = m / SEQ, s = m % SEQ; lft[(size_t)(b * FH + n) * SEQ + s] = logsigmoid_f(a * rs(m) + bias[n]); } };
struct EpMerge { const bf16_t* gr; const bf16_t* gf; bf16_t* out;
    __device__ void operator()(int m, int n, float a, float b) const { const size_t o = (size_t)m * D + n; out[o] = f2bf(bf2f(gr[o]) * a + bf2f(gf[o]) * b); } };

__global__ __launch_bounds__(128) void k_slow_retention(bf16_t* QR, const bf16_t* KR, const bf16_t* VR, const bf16_t* GR, const float* ret_norm) {
    const int bh = blockIdx.x, b = bh / RH, h = bh % RH, j = threadIdx.x;
    const float gamma = 1.f - exp2f(-5.f - (float)h);
    float S[128];
#pragma unroll
    for (int i = 0; i < 128; ++i) S[i] = 0.f;
    __shared__ float qs[128], ks[128], red[2];
    const float rn = ret_norm[h * 128 + j];
    for (int t = 0; t < SEQ; ++t) {
        const size_t o = (size_t)(b * SEQ + t) * 512 + h * 128 + j;
        qs[j] = bf2f(QR[o]); ks[j] = bf2f(KR[o]);
        const float v = bf2f(VR[o]), g = bf2f(GR[o]);
        __syncthreads();
        float out = 0.f;
#pragma unroll
        for (int i = 0; i < 128; ++i) { S[i] = gamma * S[i] + ks[i] * v; out += qs[i] * S[i]; }
        const float ss = wave_sum(out * out);
        if ((j & 63) == 0) red[j >> 6] = ss;
        __syncthreads();
        const float tot = red[0] + red[1];
        QR[o] = f2bf(g * (out * rsqrtf(tot * (1.f / 128.f) + EPS)) * rn);
    }
}

__global__ void k_cumsum(const float* lft, float* cum) {
    if (threadIdx.x != 0) return;
    const float* p = lft + (size_t)blockIdx.x * SEQ; float* c = cum + (size_t)blockIdx.x * SEQ;
    double a = 0.0;
    for (int s = 0; s < SEQ; ++s) { a += (double)p[s]; c[s] = (float)(a * 1.4426950408889634); }
}

__global__ __launch_bounds__(64) void k_slow_fox(bf16_t* FQ, const bf16_t* FK, const bf16_t* FV, const float* cum) {
    const int bh = blockIdx.y, b = bh / FH, h = bh % FH, qi = blockIdx.x * 64 + threadIdx.x;
    __shared__ float Ks[64][64], Vs[64][64], cs[64];
    float q[64], o[64];
    const size_t qo = (size_t)(b * SEQ + qi) * 512 + h * 64;
#pragma unroll
    for (int d = 0; d < 64; ++d) { q[d] = bf2f(FQ[qo + d]); o[d] = 0.f; }
    const float cq = cum[(size_t)bh * SEQ + qi];
    float mx = -1e30f, l = 0.f;
    const int qmax = blockIdx.x * 64 + 63;
    for (int t0 = 0; t0 <= qmax; t0 += 64) {
        __syncthreads();
        for (int e = threadIdx.x; e < 64 * 64; e += 64) { const int r = e >> 6, c = e & 63; const size_t ko = (size_t)(b * SEQ + t0 + r) * 512 + h * 64 + c; Ks[r][c] = bf2f(FK[ko]); Vs[r][c] = bf2f(FV[ko]); }
        cs[threadIdx.x] = cum[(size_t)bh * SEQ + t0 + threadIdx.x];
        __syncthreads();
        for (int kk = 0; kk < 64; ++kk) {
            if (t0 + kk > qi) break;
            float s = 0.f;
#pragma unroll
            for (int d = 0; d < 64; ++d) s += q[d] * Ks[kk][d];
            s += cq - cs[kk];
            const float mn = fmaxf(mx, s), sc = exp2f(mx - mn), p = exp2f(s - mn);
            l = l * sc + p; mx = mn;
#pragma unroll
            for (int d = 0; d < 64; ++d) o[d] = o[d] * sc + p * Vs[kk][d];
        }
    }
    const float il = 1.f / l;
#pragma unroll
    for (int d = 0; d < 64; ++d) FQ[qo + d] = f2bf(o[d] * il);
}

template <class Epi, bool DUAL>
static void slow_gemm(hipStream_t st, const bf16_t* A1, int lda1, const bf16_t* A2, int lda2, const float* W1, int ldw1, const float* W2, int ldw2, const float* gain, int N, int K, Epi epi) {
    dim3 grid((N + 63) / 64, M / 64);
    hipLaunchKernelGGL((k_slow_gemm<Epi, DUAL>), grid, dim3(256), 0, st, A1, lda1, A2, lda2, W1, ldw1, W2, ldw2, gain, N, K, epi);
}

extern "C" void kernel_launch(void* const* d_in, const int* in_sizes, int n_in, void* d_out, int out_size, void* d_ws, size_t ws_size, hipStream_t stream) {
    if (n_in != 15 || out_size != M * D || ws_size < WS_END) { fprintf(stderr, "kernel_launch: unexpected shapes (n_in %d out %d ws %zu)\n", n_in, out_size, ws_size); return; }
    const float* x_in = (const float*)d_in[0];
    const float* norm_ffn1 = (const float*)d_in[1]; const float* w_ffn1_in = (const float*)d_in[2]; const float* w_ffn1_out = (const float*)d_in[3];
    const float* norm_mix = (const float*)d_in[4]; const float* w_in = (const float*)d_in[5]; const float* b_forget = (const float*)d_in[6]; const float* ret_norm = (const float*)d_in[7];
    const float* w_o_ret = (const float*)d_in[8]; const float* w_o_fox = (const float*)d_in[9]; const float* w_out = (const float*)d_in[10];
    const float* norm_ffn2 = (const float*)d_in[11]; const float* w_ffn2_in = (const float*)d_in[12]; const float* w_ffn2_out = (const float*)d_in[13]; const float* norm_final = (const float*)d_in[14];
    unsigned char* ws = (unsigned char*)d_ws;
    float* x = (float*)d_out;
    float* rowss = (float*)(ws + WS_ROWSS); float* cs = (float*)(ws + WS_COS); float* sn = (float*)(ws + WS_SIN); float* lft = (float*)(ws + WS_LFT); float* cum = (float*)(ws + WS_CUM);
    bf16_t* XB = (bf16_t*)(ws + WS_XB); bf16_t* QR = (bf16_t*)(ws + WS_QR); bf16_t* KR = (bf16_t*)(ws + WS_KR); bf16_t* VR = (bf16_t*)(ws + WS_VR); bf16_t* GR = (bf16_t*)(ws + WS_GR);
    bf16_t* FQ = (bf16_t*)(ws + WS_FQ); bf16_t* FK = (bf16_t*)(ws + WS_FK); bf16_t* FV = (bf16_t*)(ws + WS_FV); bf16_t* GATER = (bf16_t*)(ws + WS_GATER); bf16_t* GATEF = (bf16_t*)(ws + WS_GATEF);
    bf16_t* H = (bf16_t*)(ws + WS_H); bf16_t* MERGED = (bf16_t*)(ws + WS_MERGED);

    hipMemcpyAsync(x, x_in, (size_t)M * D * 4, hipMemcpyDeviceToDevice, stream);
    hipLaunchKernelGGL(k_rope_table, dim3(SEQ * 64 / 256), dim3(256), 0, stream, cs, sn);
    const RowScale rs{rowss};
    for (int l = 0; l < DEPTH; ++l) {
        for (int half = 0; half < 2; ++half) {
            if (half == 1) {
                hipLaunchKernelGGL(k_rownorm, dim3(M / 4), dim3(256), 0, stream, x, XB, rowss);
                const float* W = w_in + (size_t)l * D * IN_COLS; const float* g = norm_mix + l * D;
                for (int h = 0; h < RH; ++h) {
                    slow_gemm<EpRope, true>(stream, XB, D, XB, D, W + C_RQ + h * 128, IN_COLS, W + C_RQ + h * 128 + 64, IN_COLS, g, 64, D, EpRope{rs, cs, sn, QR, h, 1.f});
                    slow_gemm<EpRope, true>(stream, XB, D, XB, D, W + C_RK + h * 128, IN_COLS, W + C_RK + h * 128 + 64, IN_COLS, g, 64, D, EpRope{rs, cs, sn, KR, h, 0.08838834764831845f});
                }
                slow_gemm<EpStore, false>(stream, XB, D, nullptr, 0, W + C_RV, IN_COLS, nullptr, 0, g, 512, D, EpStore{rs, VR, 512, 0, 1.f});
                slow_gemm<EpStore, false>(stream, XB, D, nullptr, 0, W + C_RG, IN_COLS, nullptr, 0, g, 512, D, EpStore{rs, GR, 512, 1, 1.f});
                slow_gemm<EpStore, false>(stream, XB, D, nullptr, 0, W + C_FQ, IN_COLS, nullptr, 0, g, 512, D, EpStore{rs, FQ, 512, 0, 0.125f * 1.4426950408889634f});
                slow_gemm<EpStore, false>(stream, XB, D, nullptr, 0, W + C_FK, IN_COLS, nullptr, 0, g, 512, D, EpStore{rs, FK, 512, 0, 1.f});
                slow_gemm<EpStore, false>(stream, XB, D, nullptr, 0, W + C_FV, IN_COLS, nullptr, 0, g, 512, D, EpStore{rs, FV, 512, 0, 1.f});
                slow_gemm<EpForget, false>(stream, XB, D, nullptr, 0, W + C_FF, IN_COLS, nullptr, 0, g, FH, D, EpForget{rs, b_forget + l * FH, lft});
                slow_gemm<EpStore, false>(stream, XB, D, nullptr, 0, W + C_GR, IN_COLS, nullptr, 0, g, D, D, EpStore{rs, GATER, D, 2, 1.f});
                slow_gemm<EpStore, false>(stream, XB, D, nullptr, 0, W + C_GF, IN_COLS, nullptr, 0, g, D, D, EpStore{rs, GATEF, D, 2, 1.f});
                hipLaunchKernelGGL(k_slow_retention, dim3(BATCH * RH), dim3(128), 0, stream, QR, KR, VR, GR, ret_norm + l * 512);
                hipLaunchKernelGGL(k_cumsum, dim3(BATCH * FH), dim3(64), 0, stream, lft, cum);
                hipLaunchKernelGGL(k_slow_fox, dim3(SEQ / 64, BATCH * FH), dim3(64), 0, stream, FQ, FK, FV, cum);
                slow_gemm<EpMerge, true>(stream, QR, 512, FQ, 512, w_o_ret + (size_t)l * 512 * D, D, w_o_fox + (size_t)l * 512 * D, D, nullptr, D, 512, EpMerge{GATER, GATEF, MERGED});
                slow_gemm<EpResid, false>(stream, MERGED, D, nullptr, 0, w_out + (size_t)l * D * D, D, nullptr, 0, nullptr, D, D, EpResid{x, 1.f});
            }
            const float* wi = (half == 0 ? w_ffn1_in : w_ffn2_in) + (size_t)l * D * 2 * DFF;
            const float* wo = (half == 0 ? w_ffn1_out : w_ffn2_out) + (size_t)l * DFF * D;
            const float* g = (half == 0 ? norm_ffn1 : norm_ffn2) + l * D;
            hipLaunchKernelGGL(k_rownorm, dim3(M / 4), dim3(256), 0, stream, x, XB, rowss);
            slow_gemm<EpSwiglu, true>(stream, XB, D, XB, D, wi, 2 * DFF, wi + DFF, 2 * DFF, g, DFF, D, EpSwiglu{rs, H});
            slow_gemm<EpResid, false>(stream, H, DFF, nullptr, 0, wo, D, nullptr, 0, nullptr, D, DFF, EpResid{x, 0.5f});
        }
    }
    hipLaunchKernelGGL(k_final_norm, dim3(M / 4), dim3(256), 0, stream, x, norm_final);
}
```

```cpp
#include <hip/hip_runtime.h>
#include <cstdio>
#include <cstdint>

typedef unsigned short bf16_t;

constexpr int D = 1024, BATCH = 4, SEQ = 4096, DEPTH = 4, M = BATCH * SEQ;
constexpr int RH = 4, RDK = 128, FH = 8, FD = 64, DFF = 2816, IN_COLS = 5640;
constexpr int NIN = 5888;
constexpr float EPS = 1e-6f;
constexpr int C_RQ = 0, C_RK = 512, C_RV = 1024, C_RG = 1536, C_FQ = 2048, C_FK = 2560, C_FV = 3072, C_FF = 3584, C_GR = 3592, C_GF = 4616;
constexpr float FOX_C2 = 0.125f * 1.4426950408889634f;
constexpr float RET_KSCALE = 0.08838834764831845f;

constexpr size_t MiB = 1u << 20;
constexpr size_t WS_CTL = 0, CTL_BYTES = 1 * MiB;
constexpr size_t WS_PART = 1 * MiB;
constexpr size_t WS_COS = 2 * MiB, WS_SIN = 3 * MiB;
constexpr size_t WS_LFT = 4 * MiB;
constexpr size_t WS_CUM = 4 * MiB + 512 * 1024;
constexpr size_t WS_XB = 8 * MiB;
constexpr size_t WS_KVS = 8 * MiB;
constexpr size_t WS_QR = 40 * MiB, WS_KR = 56 * MiB, WS_VR = 72 * MiB, WS_GR = 88 * MiB, WS_FQ = 104 * MiB, WS_FK = 120 * MiB, WS_FV = 136 * MiB;
constexpr size_t WS_GATER = 152 * MiB, WS_GATEF = 184 * MiB;
constexpr size_t WS_H = 40 * MiB;
constexpr size_t WS_MERGED = 56 * MiB;
constexpr size_t WS_T = 120 * MiB;
constexpr size_t WS_W = 216 * MiB;
constexpr size_t WO_1IN = 0, WO_1OUT = 11 * MiB, WO_IN = WO_1OUT + 5632 * 1024, WO_OR = WO_IN + (size_t)NIN * 2048, WO_OF = WO_OR + MiB, WO_OUT = WO_OF + MiB,
                 WO_2IN = WO_OUT + 2 * MiB, WO_2OUT = WO_2IN + 11 * MiB, W_LAYER = WO_2OUT + 5632 * 1024;
constexpr size_t WS_END = WS_W + DEPTH * W_LAYER;
static_assert(W_LAYER == 48 * MiB + 512 * 1024, "weights per layer");

constexpr int CW_BAR = 4096;

#define GAS __attribute__((address_space(1)))
#define LAS __attribute__((address_space(3)))
__device__ __forceinline__ float bf2f(bf16_t v) { return __uint_as_float((unsigned)v << 16); }
__device__ __forceinline__ bf16_t f2bf(float f) { unsigned u = __float_as_uint(f); return (bf16_t)((u + 0x7fffu + ((u >> 16) & 1u)) >> 16); }
__device__ __forceinline__ unsigned pk2(float lo, float hi) { return (unsigned)f2bf(lo) | ((unsigned)f2bf(hi) << 16); }
__device__ __forceinline__ float silu_f(float v) { return v / (1.f + __expf(-v)); }
__device__ __forceinline__ float sigmoid_f(float v) { return 1.f / (1.f + __expf(-v)); }
__device__ __forceinline__ float logsigmoid_f(float z) { return z >= 0.f ? -log1pf(expf(-z)) : z - log1pf(expf(z)); }
__device__ __forceinline__ float wave_sum(float v) {
#pragma unroll
    for (int o = 1; o < 64; o <<= 1) v += __shfl_xor(v, o);
    return v;
}
namespace pg8 {
#define PG8_LAS __attribute__((address_space(3)))
typedef unsigned short bf16_t;
typedef short bf16x8 __attribute__((ext_vector_type(8)));
typedef float f32x4 __attribute__((ext_vector_type(4)));
typedef unsigned u32x4 __attribute__((ext_vector_type(4)));
constexpr int BM = 256, BK = 64, HALF = 128, HTB = HALF * BK * 2  , STAGE_BYTES = 8 * HTB, NXCD = 8, WGM = 8;

__host__ __device__ __forceinline__ int lds_byte(int r, int c) { const int st = (r >> 4) * 2 + (c >> 5), rr = r & 15, cc = c & 31, ob = rr * 64 + cc * 2; return st * 1024 + (ob ^ (((ob >> 9) & 1) << 5)); }
__host__ __device__ __forceinline__ void stage_rc(int b, int& R, int& C) { const int st = b / 1024, sb = b % 1024, swz = sb ^ (((sb >> 9) & 1) << 5); R = (st >> 1) * 16 + swz / 64; C = (st & 1) * 32 + (swz % 64) / 2; }
__host__ __device__ __forceinline__ int perm32(int rho) { const int n = rho >> 4, i = rho & 15; return 8 * (i >> 2) + 4 * n + (i & 3); }

struct Unit { int pm, pn; };
struct Gemm { const bf16_t* A; const bf16_t* Bt; int M, N, K; };

struct StaticOrder {
    int nM, nN, nwg, G, c;
    __host__ __device__ void init(int M, int N, int G_, int c_) { nM = M / BM; nN = N / BM; nwg = nM * nN; G = G_; c = c_; }
    __host__ __device__ bool next(int i, Unit& u) const {
        const long L = (long)i * G + c; if (L >= nwg) return false;
        int wgid = (int)L; { const int q = nwg / NXCD, r = nwg % NXCD, xcd = wgid % NXCD, off = wgid / NXCD; wgid = (xcd < r ? xcd * (q + 1) : r * (q + 1) + (xcd - r) * q) + off; }
        const int nig = WGM * nN, gid = wgid / nig, fm = gid * WGM, gsz = (nM - fm) < WGM ? (nM - fm) : WGM;
        u.pm = fm + ((wgid % nig) % gsz); u.pn = (wgid % nig) / gsz; return true;
    }
    __device__ __forceinline__ void a_ready(const Unit&) const {}
    __device__ __forceinline__ void done(const Unit&) const {}
};
template <class Epi, class Sched, bool ALIGN_EPI = false, bool SP2 = false>
__device__ __forceinline__ void gemm_phase(PG8_LAS unsigned char* lds, const Gemm g, const Sched& S, const Epi& E) {
    int tid_ = threadIdx.x; asm volatile("" : "+v"(tid_));
    const int tid = tid_, wid = __builtin_amdgcn_readfirstlane(tid >> 6), lane = tid & 63, wr = wid >> 2, wc = wid & 3, fr = lane & 15, fq = lane >> 4;
    const int K = g.K, nt = K / BK;
    unsigned voffA[2], voffB[2];
#pragma unroll
    for (int i = 0; i < 2; ++i) { int R, C; stage_rc(tid * 16 + i * 8192, R, C); const int Rb = Epi::PERM ? ((R & ~31) + perm32(R & 31)) : R;
        voffA[i] = (unsigned)(R * K + C) * 2u; voffB[i] = (unsigned)(Rb * K + C) * 2u; }
    const size_t kstep = (size_t)(BK * 2);
    const size_t hstep = (size_t)HALF * K * 2;
    const size_t tstep = 2 * hstep;
    const unsigned ldsw = (unsigned)wid * 1024u;
    const int aoff = lds_byte(wr * 64 + fr, fq * 8), boff = lds_byte(wc * 32 + fr, fq * 8);
#define PG8_SA(b, h) (((b) * 2 + (h)) * HTB)
#define PG8_SB(b, h) ((4 + (b) * 2 + (h)) * HTB)
#define PG8_STAGE(bufoff, gbase, voff) do { _Pragma("unroll") for (int _i = 0; _i < 2; ++_i) \
        __builtin_amdgcn_global_load_lds((const unsigned*)((const char*)(gbase) + (voff)[_i]), (PG8_LAS unsigned*)(lds + (bufoff) + ldsw + _i * 8192), 16, 0, 0); } while (0)
#define PG8_LDA(dst, b, h) do { _Pragma("unroll") for (int m = 0; m < 4; ++m) _Pragma("unroll") for (int k = 0; k < 2; ++k) dst[m][k] = *(const PG8_LAS bf16x8*)(lds + PG8_SA(b, h) + aoff + m * 2048 + k * 1024); } while (0)
#define PG8_LDB(dst, b, h) do { _Pragma("unroll") for (int n = 0; n < 2; ++n) _Pragma("unroll") for (int k = 0; k < 2; ++k) dst[n][k] = *(const PG8_LAS bf16x8*)(lds + PG8_SB(b, h) + boff + n * 2048 + k * 1024); } while (0)
#define PG8_MMA(ai, bj, At, Bt) do { __builtin_amdgcn_s_setprio(1); _Pragma("unroll") for (int m = 0; m < 4; ++m) _Pragma("unroll") for (int n = 0; n < 2; ++n) _Pragma("unroll") for (int k = 0; k < 2; ++k) \
        acc[ai][bj][m][n] = __builtin_amdgcn_mfma_f32_16x16x32_bf16(Bt[n][k], At[m][k], acc[ai][bj][m][n], 0, 0, 0); __builtin_amdgcn_s_setprio(0); } while (0)
#define PG8_WAIT_V(n) asm volatile("s_waitcnt vmcnt(" #n ")" ::: "memory")
#define PG8_WAIT_L(n) asm volatile("s_waitcnt lgkmcnt(" #n ")" ::: "memory")
#define PG8_BAR __builtin_amdgcn_s_barrier()
#define PG8_SCHED __builtin_amdgcn_sched_barrier(0)
    Unit cur, nxt; int ui = 0;
    if (!S.next(0, cur)) return;
    f32x4 acc[2][2][4][2];
#pragma unroll
    for (int a = 0; a < 2; ++a)
#pragma unroll
        for (int b = 0; b < 2; ++b)
#pragma unroll
            for (int m = 0; m < 4; ++m)
#pragma unroll
                for (int n = 0; n < 2; ++n) acc[a][b][m][n] = (f32x4){0.f, 0.f, 0.f, 0.f};
    bf16x8 At[4][2], B0[2][2], B1[2][2];
    const char* cA = (const char*)g.A + (size_t)cur.pm * tstep; const char* cB = (const char*)g.Bt + (size_t)cur.pn * tstep;
    S.a_ready(cur);
    if constexpr (SP2) {
        PG8_STAGE(PG8_SB(0, 0), cB, voffB); PG8_STAGE(PG8_SB(0, 1), cB + hstep, voffB); PG8_STAGE(PG8_SA(0, 0), cA, voffA); PG8_STAGE(PG8_SA(0, 1), cA + hstep, voffA);
        if (wr == 1) PG8_BAR;
        PG8_WAIT_V(2); PG8_BAR;
        PG8_STAGE(PG8_SB(1, 0), cB + kstep, voffB); PG8_STAGE(PG8_SA(1, 0), cA + kstep, voffA); PG8_STAGE(PG8_SB(1, 1), cB + hstep + kstep, voffB);
        PG8_WAIT_V(6); PG8_BAR;
    } else {
        PG8_STAGE(PG8_SB(0, 0), cB, voffB); PG8_STAGE(PG8_SA(0, 0), cA, voffA); PG8_STAGE(PG8_SB(0, 1), cB + hstep, voffB); PG8_STAGE(PG8_SA(0, 1), cA + hstep, voffA);
        if (wr == 1) PG8_BAR;
        PG8_WAIT_V(4); PG8_BAR;
        PG8_STAGE(PG8_SB(1, 0), cB + kstep, voffB); PG8_STAGE(PG8_SA(1, 0), cA + kstep, voffA); PG8_STAGE(PG8_SB(1, 1), cB + hstep + kstep, voffB);
        PG8_WAIT_V(6); PG8_BAR;
    }
    for (;;) {
        const bool has_next = S.next(ui + 1, nxt);
        const char* nA = has_next ? (const char*)g.A + (size_t)nxt.pm * tstep : cA; const char* nB = has_next ? (const char*)g.Bt + (size_t)nxt.pn * tstep : cB;
        for (int t = 0; t < nt; t += 2) {
            const bool last = (t == nt - 2);
            const char* a1 = cA + (size_t)(t + 1) * kstep;
            const char* a2 = last ? nA : cA + (size_t)(t + 2) * kstep; const char* b2 = last ? nB : cB + (size_t)(t + 2) * kstep;
            const char* a3 = a2 + kstep; const char* b3 = b2 + kstep;
            if (last && has_next) S.a_ready(nxt);
            if constexpr (SP2) {
            PG8_LDB(B0, 0, 0); PG8_LDB(B1, 0, 1); PG8_SCHED; PG8_LDA(At, 0, 0); PG8_STAGE(PG8_SA(1, 1), a1 + hstep, voffA);
            PG8_WAIT_V(8); PG8_WAIT_L(0); PG8_BAR; PG8_MMA(0, 0, At, B0); PG8_MMA(0, 1, At, B1); PG8_BAR; PG8_SCHED;
            PG8_LDA(At, 0, 1); PG8_STAGE(PG8_SB(0, 0), b2, voffB); PG8_STAGE(PG8_SB(0, 1), b2 + hstep, voffB); PG8_STAGE(PG8_SA(0, 0), a2, voffA);
            PG8_WAIT_V(8); PG8_WAIT_L(0); PG8_BAR; PG8_MMA(1, 0, At, B0); PG8_MMA(1, 1, At, B1); PG8_BAR; PG8_SCHED;
            PG8_LDB(B0, 1, 0); PG8_LDB(B1, 1, 1); PG8_SCHED; PG8_LDA(At, 1, 0); PG8_STAGE(PG8_SA(0, 1), a2 + hstep, voffA);
            PG8_WAIT_V(8); PG8_WAIT_L(0); PG8_BAR; PG8_MMA(0, 0, At, B0); PG8_MMA(0, 1, At, B1); PG8_BAR; PG8_SCHED;
            PG8_LDA(At, 1, 1); PG8_STAGE(PG8_SB(1, 0), b3, voffB); PG8_STAGE(PG8_SB(1, 1), b3 + hstep, voffB); PG8_STAGE(PG8_SA(1, 0), a3, voffA);
            PG8_WAIT_V(8); PG8_WAIT_L(0); PG8_BAR; PG8_MMA(1, 0, At, B0); PG8_MMA(1, 1, At, B1); PG8_BAR; PG8_SCHED;
            } else {
            PG8_LDB(B0, 0, 0); PG8_SCHED; PG8_LDA(At, 0, 0); PG8_STAGE(PG8_SA(1, 1), a1 + hstep, voffA);
            PG8_WAIT_L(8); PG8_BAR; PG8_WAIT_L(0); PG8_MMA(0, 0, At, B0); PG8_BAR; PG8_SCHED;
            PG8_LDB(B1, 0, 1); PG8_STAGE(PG8_SB(0, 0), b2, voffB);
            PG8_BAR; PG8_WAIT_L(0); PG8_MMA(0, 1, At, B1); PG8_BAR;
            PG8_LDA(At, 0, 1); PG8_STAGE(PG8_SA(0, 0), a2, voffA);
            PG8_BAR; PG8_WAIT_L(0); PG8_MMA(1, 0, At, B0); PG8_BAR; PG8_SCHED;
            PG8_STAGE(PG8_SB(0, 1), b2 + hstep, voffB);
            PG8_WAIT_V(6); PG8_BAR; PG8_MMA(1, 1, At, B1); PG8_BAR;
            PG8_LDB(B0, 1, 0); PG8_SCHED; PG8_LDA(At, 1, 0); PG8_STAGE(PG8_SA(0, 1), a2 + hstep, voffA);
            PG8_WAIT_L(8); PG8_BAR; PG8_WAIT_L(0); PG8_MMA(0, 0, At, B0); PG8_BAR; PG8_SCHED;
            PG8_LDB(B1, 1, 1); PG8_STAGE(PG8_SB(1, 0), b3, voffB);
            PG8_BAR; PG8_WAIT_L(0); PG8_MMA(0, 1, At, B1); PG8_BAR;
            PG8_LDA(At, 1, 1); PG8_STAGE(PG8_SA(1, 0), a3, voffA);
            PG8_BAR; PG8_WAIT_L(0); PG8_MMA(1, 0, At, B0); PG8_BAR; PG8_SCHED;
            PG8_STAGE(PG8_SB(1, 1), b3 + hstep, voffB);
            PG8_WAIT_V(6); PG8_BAR; PG8_MMA(1, 1, At, B1); PG8_BAR;
            }
        }
        if constexpr (ALIGN_EPI) { if (wr == 0) PG8_BAR; }
        if constexpr (!Epi::AFTER_DRAIN) { E(acc, cur, wr, wc, fr, fq); S.done(cur); }
        if (!has_next) break;
#pragma unroll
        for (int a = 0; a < 2; ++a)
#pragma unroll
            for (int b = 0; b < 2; ++b)
#pragma unroll
                for (int m = 0; m < 4; ++m)
#pragma unroll
                    for (int n = 0; n < 2; ++n) acc[a][b][m][n] = (f32x4){0.f, 0.f, 0.f, 0.f};
        cur = nxt; cA = nA; cB = nB; ++ui;
        if constexpr (ALIGN_EPI) { if (wr == 1) PG8_BAR; }
    }
    PG8_WAIT_V(0);
    if constexpr (!ALIGN_EPI) { if (wr == 0) PG8_BAR; }
    PG8_BAR;
    if constexpr (Epi::AFTER_DRAIN) { E.fused(acc, cur, wr, wc, fr, fq, lds, wid, lane); S.done(cur); }
#undef PG8_SA
#undef PG8_SB
#undef PG8_STAGE
#undef PG8_LDA
#undef PG8_LDB
#undef PG8_MMA
#undef PG8_WAIT_V
#undef PG8_WAIT_L
#undef PG8_BAR
#undef PG8_SCHED
}
}
namespace pg8 {
__device__ __forceinline__ unsigned cvt_pk_bf16(float lo, float hi) { unsigned r; asm volatile("v_cvt_pk_bf16_f32 %0, %1, %2" : "=v"(r) : "v"(lo), "v"(hi)); return r; }
__device__ __forceinline__ u32x4 pack8(const f32x4 a, const f32x4 b) { u32x4 w; w.x = cvt_pk_bf16(a[0], a[1]); w.y = cvt_pk_bf16(a[2], a[3]); w.z = cvt_pk_bf16(b[0], b[1]); w.w = cvt_pk_bf16(b[2], b[3]); return w; }
__device__ __forceinline__ f32x4 unpack_lo(const u32x4 w) { return (f32x4){__uint_as_float(w.x << 16), __uint_as_float(w.x & 0xffff0000u), __uint_as_float(w.y << 16), __uint_as_float(w.y & 0xffff0000u)}; }
__device__ __forceinline__ f32x4 unpack_hi(const u32x4 w) { return (f32x4){__uint_as_float(w.z << 16), __uint_as_float(w.z & 0xffff0000u), __uint_as_float(w.w << 16), __uint_as_float(w.w & 0xffff0000u)}; }
__device__ __forceinline__ float fast_sigmoid(float v) { return __builtin_amdgcn_rcpf(1.f + __builtin_amdgcn_exp2f(-1.4426950408889634f * v)); }
__device__ __forceinline__ f32x4 sigmoid4(const f32x4 v) { return (f32x4){fast_sigmoid(v[0]), fast_sigmoid(v[1]), fast_sigmoid(v[2]), fast_sigmoid(v[3])}; }
__device__ __forceinline__ f32x4 silu4(const f32x4 v) { return v * sigmoid4(v); }
__device__ __forceinline__ float rstd_row(const float* part, int row, int fq) {
    const f32x4 p = *(const f32x4*)(part + (size_t)row * 16 + 4 * fq);
    float s = (p[0] + p[1]) + (p[2] + p[3]);
    s += __shfl_xor(s, 16); s += __shfl_xor(s, 32);
    return rsqrtf(s * (1.f / 1024.f) + 1e-6f);
}

struct EpiSwiglu {
    static constexpr bool PERM = true, AFTER_DRAIN = false;
    bf16_t* H; const float* part;
    __device__ __forceinline__ void operator()(const f32x4 (&acc)[2][2][4][2], const Unit& u, int wr, int wc, int fr, int fq) const {
        const int row0 = u.pm * BM + wr * 64 + fr, hcol = u.pn * 128 + wc * 32 + 8 * fq;
#pragma unroll
        for (int ai = 0; ai < 2; ++ai)
#pragma unroll
            for (int m = 0; m < 4; ++m) {
                const int row = row0 + ai * HALF + m * 16; const float r = rstd_row(part, row, fq);
                const f32x4 h0 = silu4(acc[ai][0][m][0] * r) * (acc[ai][1][m][0] * r), h1 = silu4(acc[ai][0][m][1] * r) * (acc[ai][1][m][1] * r);
                *(u32x4*)(H + (size_t)row * 2816 + hcol) = pack8(h0, h1);
            }
    }
};
struct EpiResid {
    static constexpr bool PERM = true, AFTER_DRAIN = false;
    float* x; bf16_t* xb; float* part; float alpha;
    __device__ __forceinline__ void operator()(const f32x4 (&acc)[2][2][4][2], const Unit& u, int wr, int wc, int fr, int fq) const {
        const int row0 = u.pm * BM + wr * 64 + fr, col0 = u.pn * BM + wc * 32 + 8 * fq;
#pragma unroll
        for (int ai = 0; ai < 2; ++ai)
#pragma unroll
            for (int m = 0; m < 4; ++m) {
                const int row = row0 + ai * HALF + m * 16; float ss = 0.f;
#pragma unroll
                for (int bj = 0; bj < 2; ++bj) {
                    float* xp = x + (size_t)row * 1024 + col0 + bj * HALF;
                    f32x4 v0 = *(const f32x4*)xp, v1 = *(const f32x4*)(xp + 4);
                    v0 += acc[ai][bj][m][0] * alpha; v1 += acc[ai][bj][m][1] * alpha;
                    *(f32x4*)xp = v0; *(f32x4*)(xp + 4) = v1;
                    ss += (v0[0] * v0[0] + v0[1] * v0[1]) + (v0[2] * v0[2] + v0[3] * v0[3]) + (v1[0] * v1[0] + v1[1] * v1[1]) + (v1[2] * v1[2] + v1[3] * v1[3]);
                    *(u32x4*)(xb + (size_t)row * 1024 + col0 + bj * HALF) = pack8(v0, v1);
                }
                ss += __shfl_xor(ss, 16); ss += __shfl_xor(ss, 32);
                if (fq == 0) part[(size_t)row * 16 + u.pn * 4 + wc] = ss;
            }
    }
};
struct EpiInproj {
    static constexpr bool PERM = true, AFTER_DRAIN = false;
    const float* part; const float* cs; const float* sn; const float* bforget; unsigned char* ws; float* lft;
    __device__ __forceinline__ void operator()(const f32x4 (&acc)[2][2][4][2], const Unit& u, int wr, int wc, int fr, int fq) const {
        const int row0 = u.pm * BM + wr * 64 + fr, pn = u.pn;
        if (pn < 4) {
            bf16_t* dst = (bf16_t*)(ws + (pn < 2 ? WS_QR : WS_KR)); const float scale = pn < 2 ? 1.f : RET_KSCALE;
            const int head = 2 * (pn & 1) + (wc >> 1), i0 = 32 * (wc & 1) + 8 * fq;
#pragma unroll
            for (int ai = 0; ai < 2; ++ai)
#pragma unroll
                for (int m = 0; m < 4; ++m) {
                    const int row = row0 + ai * HALF + m * 16, s = row & (SEQ - 1); const float r = rstd_row(part, row, fq) * scale;
                    const f32x4 c0 = *(const f32x4*)(cs + s * 64 + i0), c1 = *(const f32x4*)(cs + s * 64 + i0 + 4), s0 = *(const f32x4*)(sn + s * 64 + i0), s1 = *(const f32x4*)(sn + s * 64 + i0 + 4);
                    const f32x4 a0 = acc[ai][0][m][0] * r, a1 = acc[ai][0][m][1] * r, b0 = acc[ai][1][m][0] * r, b1 = acc[ai][1][m][1] * r;
                    bf16_t* o = dst + (size_t)row * 512 + head * 128 + i0;
                    *(u32x4*)o = pack8(a0 * c0 - b0 * s0, a1 * c1 - b1 * s1);
                    *(u32x4*)(o + 64) = pack8(a0 * s0 + b0 * c0, a1 * s1 + b1 * c1);
                }
        } else if (pn < 22) {
            const int grp = pn < 14 ? (pn - 4) >> 1 : (pn < 18 ? 5 : 6);
            const size_t off = grp == 0 ? WS_VR : grp == 1 ? WS_GR : grp == 2 ? WS_FQ : grp == 3 ? WS_FK : grp == 4 ? WS_FV : grp == 5 ? WS_GATER : WS_GATEF;
            const int ldd = grp < 5 ? 512 : 1024, colb = grp < 5 ? 256 * (pn & 1) : 256 * ((pn - 14) & 3), act = grp == 1 ? 1 : grp >= 5 ? 2 : 0;
            const float scale = grp == 2 ? FOX_C2 : 1.f;
            bf16_t* dst = (bf16_t*)(ws + off) + colb + wc * 32 + 8 * fq;
#pragma unroll
            for (int ai = 0; ai < 2; ++ai)
#pragma unroll
                for (int m = 0; m < 4; ++m) {
                    const int row = row0 + ai * HALF + m * 16; const float r = rstd_row(part, row, fq);
#pragma unroll
                    for (int bj = 0; bj < 2; ++bj) {
                        f32x4 v0 = acc[ai][bj][m][0] * r, v1 = acc[ai][bj][m][1] * r;
                        if (act == 1) { v0 = silu4(v0); v1 = silu4(v1); } else if (act == 2) { v0 = sigmoid4(v0); v1 = sigmoid4(v1); }
                        *(u32x4*)(dst + (size_t)row * ldd + bj * HALF) = pack8(v0 * scale, v1 * scale);
                    }
                }
        } else {
#pragma unroll
            for (int ai = 0; ai < 2; ++ai)
#pragma unroll
                for (int m = 0; m < 4; ++m) {
                    const int row = row0 + ai * HALF + m * 16; const float r = rstd_row(part, row, fq);
                    if (wc == 0 && fq == 0) {
                        const int b = row >> 12, s = row & (SEQ - 1);
#pragma unroll
                        for (int n = 0; n < 2; ++n)
#pragma unroll
                            for (int e = 0; e < 4; ++e) { const int hd = 4 * n + e; lft[(size_t)(b * FH + hd) * SEQ + s] = logsigmoid_f(acc[ai][0][m][n][e] * r + bforget[hd]); }
                    }
                }
        }
    }
};
struct EpiGateT {
    static constexpr bool PERM = true, AFTER_DRAIN = false;
    const bf16_t* gate; bf16_t* T;
    __device__ __forceinline__ void operator()(const f32x4 (&acc)[2][2][4][2], const Unit& u, int wr, int wc, int fr, int fq) const {
        const int row0 = u.pm * BM + wr * 64 + fr, col0 = u.pn * BM + wc * 32 + 8 * fq;
#pragma unroll
        for (int ai = 0; ai < 2; ++ai)
#pragma unroll
            for (int m = 0; m < 4; ++m)
#pragma unroll
                for (int bj = 0; bj < 2; ++bj) {
                    const size_t o = (size_t)(row0 + ai * HALF + m * 16) * 1024 + col0 + bj * HALF;
                    const u32x4 g = *(const u32x4*)(gate + o);
                    *(u32x4*)(T + o) = pack8(unpack_lo(g) * acc[ai][bj][m][0], unpack_hi(g) * acc[ai][bj][m][1]);
                }
    }
};
struct EpiMergeF {
    static constexpr bool PERM = true, AFTER_DRAIN = false;
    const bf16_t* gate; const bf16_t* T; bf16_t* out;
    __device__ __forceinline__ void operator()(const f32x4 (&acc)[2][2][4][2], const Unit& u, int wr, int wc, int fr, int fq) const {
        const int row0 = u.pm * BM + wr * 64 + fr, col0 = u.pn * BM + wc * 32 + 8 * fq;
#pragma unroll
        for (int ai = 0; ai < 2; ++ai)
#pragma unroll
            for (int m = 0; m < 4; ++m)
#pragma unroll
                for (int bj = 0; bj < 2; ++bj) {
                    const size_t o = (size_t)(row0 + ai * HALF + m * 16) * 1024 + col0 + bj * HALF;
                    const u32x4 g = *(const u32x4*)(gate + o), t = *(const u32x4*)(T + o);
                    *(u32x4*)(out + o) = pack8(unpack_lo(t) + unpack_lo(g) * acc[ai][bj][m][0], unpack_hi(t) + unpack_hi(g) * acc[ai][bj][m][1]);
                }
    }
};
}
#define XB_TMO      128
#define XB_XCNT(j)  (256  + 64 * (j))
#define XB_XSUB(j)  (1280 + 64 * (j))
#define XB_XGEN(j)  (2304 + 64 * (j))
#define XB_TOP      3328
#define XB_TOPGEN   3392
#define XCD_BAR_WORDS 3456
#define XB_SPIN_CAP (1u << 18)

__device__ __forceinline__ unsigned xb_ld(unsigned* p)              { return __hip_atomic_load(p, __ATOMIC_RELAXED, __HIP_MEMORY_SCOPE_AGENT); }
__device__ __forceinline__ unsigned xb_add(unsigned* p, unsigned v) { return __hip_atomic_fetch_add(p, v, __ATOMIC_RELAXED, __HIP_MEMORY_SCOPE_AGENT); }
__device__ __forceinline__ unsigned xb_xcc_id() { return (unsigned)__builtin_amdgcn_s_getreg((3 << 11) | 20) & 0xFu; }
#define XB_SPIN(cond, bar) do { unsigned _sp = 0; while (cond) { __builtin_amdgcn_s_sleep(1); \
    if ((++_sp & 255u) == 0u) { if (xb_ld(&(bar)[XB_TMO])) break; if (_sp > XB_SPIN_CAP) { atomicAdd(&(bar)[XB_TMO], 1u); break; } } } } while (0)

struct XcdBarrier {
    unsigned* bar; unsigned x;
    volatile LAS unsigned* st;
};

__device__ __forceinline__ XcdBarrier xcd_barrier_post(unsigned* bar, volatile LAS unsigned* st) {
    XcdBarrier b; b.bar = bar; b.x = xb_xcc_id(); b.st = st;
    if (threadIdx.x == 0) (void)xb_add(&bar[XB_XCNT(b.x)], 1u);
    return b;
}
__device__ __forceinline__ void xcd_barrier_complete(unsigned* bar, unsigned x, unsigned& nloc, unsigned& nx) {
    const unsigned G = gridDim.x * gridDim.y * gridDim.z;
    unsigned sum, cnt, mine, sp = 0u;
    for (;;) {
        sum = 0u; cnt = 0u; mine = 0u;
#pragma unroll
        for (unsigned j = 0; j < 16; ++j) { const unsigned c = xb_ld(&bar[XB_XCNT(j)]); sum += c; cnt += (c > 0u) ? 1u : 0u; mine = (j == x) ? c : mine; }
        if (sum == G) break;
        __builtin_amdgcn_s_sleep(1);
        if ((++sp & 255u) == 0u) { if (xb_ld(&bar[XB_TMO])) break; if (sp > XB_SPIN_CAP) { atomicAdd(&bar[XB_TMO], 1u); break; } }
    }
    nloc = mine > 0u ? mine : 1u; nx = cnt > 0u ? cnt : 1u;
}

__device__ __forceinline__ void xcd_barrier(const XcdBarrier& b) {
    asm volatile("s_waitcnt vmcnt(0)" ::: "memory");
    __syncthreads();
    if (threadIdx.x == 0) {
        unsigned* bar = b.bar;
        __builtin_amdgcn_s_waitcnt(0);
        unsigned nloc = b.st[0], nx = b.st[1];
        if (nloc == 0u) { xcd_barrier_complete(bar, b.x, nloc, nx); b.st[0] = nloc; b.st[1] = nx; }
        const unsigned old = xb_add(&bar[XB_XSUB(b.x)], 1u);
        const unsigned gen = old / nloc;
        if (old + 1u == (gen + 1u) * nloc) {
            __builtin_amdgcn_fence(__ATOMIC_RELEASE, "agent");
            asm volatile("s_waitcnt vmcnt(0)" ::: "memory");
            const unsigned og = xb_add(&bar[XB_TOP], 1u);
            const unsigned tg = og / nx;
            if (og + 1u == (tg + 1u) * nx) xb_add(&bar[XB_TOPGEN], 1u);
            else XB_SPIN(xb_ld(&bar[XB_TOPGEN]) == tg, bar);
            __builtin_amdgcn_fence(__ATOMIC_ACQUIRE, "agent");
            xb_add(&bar[XB_XGEN(b.x)], 1u);
            asm volatile("s_waitcnt vmcnt(0)" ::: "memory");
        } else {
            XB_SPIN(xb_ld(&bar[XB_XGEN(b.x)]) == gen, bar);
            __builtin_amdgcn_fence(__ATOMIC_ACQUIRE, "agent");
            asm volatile("s_waitcnt vmcnt(0)" ::: "memory");
        }
    }
    __syncthreads();
}
constexpr int NWAVES = 8;
constexpr int RING_OFF = 0, RING_BYTES = 131072;
constexpr int LDSCTL_OFF = RING_BYTES, MISC_OFF = LDSCTL_OFF + 320;
constexpr int LDS_BYTES = 147456;
typedef GAS unsigned gu32;
typedef unsigned v4u __attribute__((ext_vector_type(4)));
typedef float f32x4 __attribute__((ext_vector_type(4)));
#define LDS_WAIT() asm volatile("s_waitcnt lgkmcnt(0)" ::: "memory")
#define VM_WAIT() asm volatile("s_waitcnt vmcnt(0)" ::: "memory")

struct Args { const float* in[15]; float* out; unsigned char* ws; int ph_lo, ph_hi, li, pad; };
enum { IN_X = 0, IN_NORM1, IN_W1IN, IN_W1OUT, IN_NORMMIX, IN_WIN, IN_BFORGET, IN_RETNORM, IN_WORET, IN_WOFOX, IN_WOUT, IN_NORM2, IN_W2IN, IN_W2OUT, IN_NORMFINAL };

struct Frame {
    LAS unsigned char* lds;
    volatile LAS unsigned* MISC;
    int tid, lane, wave, vcu, G;
};

__device__ __forceinline__ void p0_transpose_item(const float* W, int ldw, int srccol, int nvalid, const float* gain, int K, bf16_t* WT, int drow0, int k0, LAS float* scr, int lane) {
    const int n = lane & 31;
#pragma unroll 8
    for (int i = 0; i < 32; ++i) { const int kk = 2 * i + (lane >> 5);
        float v = 0.f; if (n < nvalid) { v = W[(size_t)(k0 + kk) * ldw + srccol + n]; if (gain) v *= gain[k0 + kk]; }
        scr[kk * 33 + n] = v; }
    LDS_WAIT(); asm volatile("" ::: "memory");
    const int c = lane & 7;
#pragma unroll
    for (int j = 0; j < 4; ++j) { const int nn = (lane >> 3) + 8 * j; const LAS float* s = scr + (8 * c) * 33 + nn;
        v4u o; o.x = pk2(s[0 * 33], s[1 * 33]); o.y = pk2(s[2 * 33], s[3 * 33]); o.z = pk2(s[4 * 33], s[5 * 33]); o.w = pk2(s[6 * 33], s[7 * 33]);
        *(GAS v4u*)(WT + (size_t)(drow0 + nn) * K + k0 + 8 * c) = o; }
    LDS_WAIT(); asm volatile("" ::: "memory");
}
__device__ __forceinline__ int src_col32(int kind, int rho0, int& nvalid) {
    nvalid = 32;
    if (kind == 0) return rho0;
    const int pn = rho0 >> 8, bj = (rho0 >> 7) & 1, j = rho0 & 127;
    if (kind == 1) return (bj ? DFF : 0) + 128 * pn + j;
    if (pn < 4) return (pn < 2 ? C_RQ : C_RK) + (2 * (pn & 1) + (j >> 6)) * 128 + 64 * bj + (j & 63);
    if (pn < 14) return rho0;
    if (pn < 22) return rho0 + 8;
    nvalid = (rho0 == 22 * 256) ? 8 : 0; return C_FF;
}
__device__ __forceinline__ void p0_convert(const float* W, int ldw, const float* gain, int K, bf16_t* WT, int N, int kind, int gw, int NGW, int& base, LAS float* scr, int lane) {
    const int nblk = N / 32, nitems = (K / 64) * nblk;
    int first = gw - (base % NGW); if (first < 0) first += NGW;
    for (int it = first; it < nitems; it += NGW) {
        const int kb = it / nblk, nb = it % nblk; int nvalid; const int sc = src_col32(kind, 32 * nb, nvalid);
        p0_transpose_item(W, ldw, sc, nvalid, gain, K, WT, 32 * nb, 64 * kb, scr, lane);
    }
    base += nitems;
}

constexpr int PH_PER_LAYER = 10, PH_FINAL = 1 + DEPTH * PH_PER_LAYER, N_PHASES = PH_FINAL + 1;
__global__ void __launch_bounds__(NWAVES * 64, 2) mega(Args args) {
    extern __shared__ __attribute__((aligned(16))) unsigned char lds[];
    Frame F;
    F.lds = (LAS unsigned char*)lds;
    F.MISC = (volatile LAS unsigned*)(F.lds + MISC_OFF);
    F.tid = threadIdx.x; F.lane = F.tid & 63; F.wave = __builtin_amdgcn_readfirstlane(F.tid >> 6);
    F.G = gridDim.x; { const int bx = blockIdx.x; F.vcu = (F.G % 8 == 0) ? (bx % 8) * (F.G / 8) + bx / 8 : bx; }
    unsigned char* ws = args.ws;
    gu32* ctl = (gu32*)(ws + WS_CTL);
    for (int u = F.tid; u < (LDS_BYTES - LDSCTL_OFF) / 4; u += NWAVES * 64) ((LAS unsigned*)(F.lds + LDSCTL_OFF))[u] = 0u;
    __syncthreads();
    XcdBarrier bar = xcd_barrier_post((unsigned*)(ctl + CW_BAR) + args.li * XCD_BAR_WORDS, F.MISC + 8);
    const int lo = args.ph_lo, hi = args.ph_hi;
#define IN(k) (lo <= (k) && (k) < hi)
#define SEAM(k) do { if (IN(k) && IN((k) + 1)) xcd_barrier(bar); } while (0)
    float* x = args.out;
    float* part = (float*)(ws + WS_PART);
    bf16_t* XB = (bf16_t*)(ws + WS_XB); bf16_t* HB = (bf16_t*)(ws + WS_H);
    const int gw = F.vcu * NWAVES + F.wave, NGW = F.G * NWAVES;

    if (IN(0)) {
        LAS float* scr = (LAS float*)(F.lds + RING_OFF + F.wave * 16384);
        int base = 0;
        for (int l = 0; l < DEPTH; ++l) {
            unsigned char* wl = ws + WS_W + (size_t)l * W_LAYER;
            p0_convert(args.in[IN_W1IN] + (size_t)l * D * 2 * DFF, 2 * DFF, args.in[IN_NORM1] + l * D, D, (bf16_t*)(wl + WO_1IN), 2 * DFF, 1, gw, NGW, base, scr, F.lane);
            p0_convert(args.in[IN_W1OUT] + (size_t)l * DFF * D, D, nullptr, DFF, (bf16_t*)(wl + WO_1OUT), D, 0, gw, NGW, base, scr, F.lane);
            p0_convert(args.in[IN_WIN] + (size_t)l * D * IN_COLS, IN_COLS, args.in[IN_NORMMIX] + l * D, D, (bf16_t*)(wl + WO_IN), NIN, 2, gw, NGW, base, scr, F.lane);
            p0_convert(args.in[IN_WORET] + (size_t)l * 512 * D, D, nullptr, 512, (bf16_t*)(wl + WO_OR), D, 0, gw, NGW, base, scr, F.lane);
            p0_convert(args.in[IN_WOFOX] + (size_t)l * 512 * D, D, nullptr, 512, (bf16_t*)(wl + WO_OF), D, 0, gw, NGW, base, scr, F.lane);
            p0_convert(args.in[IN_WOUT] + (size_t)l * D * D, D, nullptr, D, (bf16_t*)(wl + WO_OUT), D, 0, gw, NGW, base, scr, F.lane);
            p0_convert(args.in[IN_W2IN] + (size_t)l * D * 2 * DFF, 2 * DFF, args.in[IN_NORM2] + l * D, D, (bf16_t*)(wl + WO_2IN), 2 * DFF, 1, gw, NGW, base, scr, F.lane);
            p0_convert(args.in[IN_W2OUT] + (size_t)l * DFF * D, D, nullptr, DFF, (bf16_t*)(wl + WO_2OUT), D, 0, gw, NGW, base, scr, F.lane);
        }
        {
            float* cs = (float*)(ws + WS_COS); float* sn = (float*)(ws + WS_SIN);
            for (int idx = gw * 64 + F.lane; idx < SEQ * 64; idx += NGW * 64) { const int s = idx >> 6, i = idx & 63;
                const double inv = pow(10000.0, -(double)(2 * i) / 128.0), a = (double)s * inv; cs[idx] = (float)cos(a); sn[idx] = (float)sin(a); }
        }
        const float* xin = args.in[IN_X];
        for (int m = gw; m < M; m += NGW) {
            const GAS f32x4* xr = (const GAS f32x4*)(xin + (size_t)m * D) + F.lane; float s = 0.f;
#pragma unroll
            for (int j = 0; j < 4; ++j) { const f32x4 v = xr[64 * j]; s += (v[0] * v[0] + v[1] * v[1]) + (v[2] * v[2] + v[3] * v[3]);
                ((GAS f32x4*)(x + (size_t)m * D))[F.lane + 64 * j] = v;
                ((GAS unsigned long long*)(XB + (size_t)m * D))[F.lane + 64 * j] = (unsigned long long)pk2(v[0], v[1]) | ((unsigned long long)pk2(v[2], v[3]) << 32); }
            s = wave_sum(s);
            if (F.lane < 16) part[(size_t)m * 16 + F.lane] = F.lane == 0 ? s : 0.f;
        }
    }
    SEAM(0);

    for (int hl = 0; hl < 2 * DEPTH; ++hl) {
        const int l = hl >> 1, odd = hl & 1, pb = 1 + l * PH_PER_LAYER;
        unsigned char* wl = ws + WS_W + (size_t)l * W_LAYER;
        if (odd) {
        if (IN(pb + 2)) {
            pg8::Gemm g{XB, (const bf16_t*)(wl + WO_IN), M, NIN, D}; pg8::StaticOrder S; S.init(M, NIN, F.G, (int)blockIdx.x);
            pg8::EpiInproj E{part, (const float*)(ws + WS_COS), (const float*)(ws + WS_SIN), args.in[IN_BFORGET] + l * FH, ws, (float*)(ws + WS_LFT)};
            pg8::gemm_phase<pg8::EpiInproj, pg8::StaticOrder, true, true>(F.lds + RING_OFF, g, S, E);
        }
        SEAM(pb + 2);
        SEAM(pb + 3); SEAM(pb + 4); SEAM(pb + 5);
        if (IN(pb + 6)) {
            { pg8::Gemm g{(const bf16_t*)(ws + WS_QR), (const bf16_t*)(wl + WO_OR), M, D, 512}; pg8::StaticOrder S; S.init(M, D, F.G, (int)blockIdx.x);
              pg8::EpiGateT E{(const bf16_t*)(ws + WS_GATER), (bf16_t*)(ws + WS_T)}; pg8::gemm_phase<pg8::EpiGateT, pg8::StaticOrder, true, true>(F.lds + RING_OFF, g, S, E); }
            VM_WAIT(); __syncthreads(); __builtin_amdgcn_fence(__ATOMIC_ACQUIRE, "agent"); VM_WAIT(); __syncthreads();
            { pg8::Gemm g{(const bf16_t*)(ws + WS_FQ), (const bf16_t*)(wl + WO_OF), M, D, 512}; pg8::StaticOrder S; S.init(M, D, F.G, (int)blockIdx.x);
              pg8::EpiMergeF E{(const bf16_t*)(ws + WS_GATEF), (const bf16_t*)(ws + WS_T), (bf16_t*)(ws + WS_MERGED)}; pg8::gemm_phase<pg8::EpiMergeF, pg8::StaticOrder, true, true>(F.lds + RING_OFF, g, S, E); }
        }
        SEAM(pb + 6);
        if (IN(pb + 7)) {
            pg8::Gemm g{(const bf16_t*)(ws + WS_MERGED), (const bf16_t*)(wl + WO_OUT), M, D, D}; pg8::StaticOrder S; S.init(M, D, F.G, (int)blockIdx.x);
            pg8::EpiResid E{x, XB, part, 1.f}; pg8::gemm_phase<pg8::EpiResid, pg8::StaticOrder, true, true>(F.lds + RING_OFF, g, S, E);
        }
        SEAM(pb + 7);
        }
        const int kin = pb + (odd ? 8 : 0), kout = kin + 1;
        if (IN(kin)) { pg8::Gemm g{XB, (const bf16_t*)(wl + (odd ? WO_2IN : WO_1IN)), M, 2 * DFF, D}; pg8::StaticOrder S; S.init(M, 2 * DFF, F.G, (int)blockIdx.x);
            pg8::EpiSwiglu E{HB, part}; pg8::gemm_phase<pg8::EpiSwiglu, pg8::StaticOrder, true, true>(F.lds + RING_OFF, g, S, E); }
        SEAM(kin);
        if (IN(kout)) { pg8::Gemm g{HB, (const bf16_t*)(wl + (odd ? WO_2OUT : WO_1OUT)), M, D, DFF}; pg8::StaticOrder S; S.init(M, D, F.G, (int)blockIdx.x);
            pg8::EpiResid E{x, XB, part, 0.5f}; pg8::gemm_phase<pg8::EpiResid, pg8::StaticOrder, true, true>(F.lds + RING_OFF, g, S, E); }
        SEAM(kout);
    }
    if (IN(PH_FINAL)) {
        const float* g = args.in[IN_NORMFINAL];
        for (int m = gw; m < M; m += NGW) {
            float ps = F.lane < 16 ? part[(size_t)m * 16 + F.lane] : 0.f; ps = wave_sum(ps);
            const float rstd = rsqrtf(ps * (1.f / D) + EPS);
            GAS f32x4* xr = (GAS f32x4*)(x + (size_t)m * D) + F.lane;
#pragma unroll
            for (int j = 0; j < 4; ++j) { const f32x4 v = xr[64 * j], gg = ((const GAS f32x4*)g)[F.lane + 64 * j]; xr[64 * j] = v * rstd * gg; }
        }
    }
#undef IN
#undef SEAM
}
__global__ __launch_bounds__(128) void k_slow_retention(bf16_t* QR, const bf16_t* KR, const bf16_t* VR, const bf16_t* GR, const float* ret_norm) {
    const int bh = blockIdx.x, b = bh / RH, h = bh % RH, j = threadIdx.x;
    const float gamma = 1.f - exp2f(-5.f - (float)h);
    float S[128];
#pragma unroll
    for (int i = 0; i < 128; ++i) S[i] = 0.f;
    __shared__ float qs[128], ks[128], red[2];
    const float rn = ret_norm[h * 128 + j];
    for (int t = 0; t < SEQ; ++t) {
        const size_t o = (size_t)(b * SEQ + t) * 512 + h * 128 + j;
        qs[j] = bf2f(QR[o]); ks[j] = bf2f(KR[o]);
        const float v = bf2f(VR[o]), g = bf2f(GR[o]);
        __syncthreads();
        float out = 0.f;
#pragma unroll
        for (int i = 0; i < 128; ++i) { S[i] = gamma * S[i] + ks[i] * v; out += qs[i] * S[i]; }
        const float ss = wave_sum(out * out);
        if ((j & 63) == 0) red[j >> 6] = ss;
        __syncthreads();
        const float tot = red[0] + red[1];
        QR[o] = f2bf(g * (out * rsqrtf(tot * (1.f / 128.f) + EPS)) * rn);
    }
}

__global__ void k_cumsum(const float* lft, float* cum) {
    if (threadIdx.x != 0) return;
    const float* p = lft + (size_t)blockIdx.x * SEQ; float* c = cum + (size_t)blockIdx.x * SEQ;
    double a = 0.0;
    for (int s = 0; s < SEQ; ++s) { a += (double)p[s]; c[s] = (float)(a * 1.4426950408889634); }
}

__global__ __launch_bounds__(64) void k_slow_fox(bf16_t* FQ, const bf16_t* FK, const bf16_t* FV, const float* cum) {
    const int bh = blockIdx.y, b = bh / FH, h = bh % FH, qi = blockIdx.x * 64 + threadIdx.x;
    __shared__ float Ks[64][64], Vs[64][64], cs[64];
    float q[64], o[64];
    const size_t qo = (size_t)(b * SEQ + qi) * 512 + h * 64;
#pragma unroll
    for (int d = 0; d < 64; ++d) { q[d] = bf2f(FQ[qo + d]); o[d] = 0.f; }
    const float cq = cum[(size_t)bh * SEQ + qi];
    float mx = -1e30f, l = 0.f;
    const int qmax = blockIdx.x * 64 + 63;
    for (int t0 = 0; t0 <= qmax; t0 += 64) {
        __syncthreads();
        for (int e = threadIdx.x; e < 64 * 64; e += 64) { const int r = e >> 6, c = e & 63; const size_t ko = (size_t)(b * SEQ + t0 + r) * 512 + h * 64 + c; Ks[r][c] = bf2f(FK[ko]); Vs[r][c] = bf2f(FV[ko]); }
        cs[threadIdx.x] = cum[(size_t)bh * SEQ + t0 + threadIdx.x];
        __syncthreads();
        for (int kk = 0; kk < 64; ++kk) {
            if (t0 + kk > qi) break;
            float s = 0.f;
#pragma unroll
            for (int d = 0; d < 64; ++d) s += q[d] * Ks[kk][d];
            s += cq - cs[kk];
            const float mn = fmaxf(mx, s), sc = exp2f(mx - mn), p = exp2f(s - mn);
            l = l * sc + p; mx = mn;
#pragma unroll
            for (int d = 0; d < 64; ++d) o[d] = o[d] * sc + p * Vs[kk][d];
        }
    }
    const float il = 1.f / l;
#pragma unroll
    for (int d = 0; d < 64; ++d) FQ[qo + d] = f2bf(o[d] * il);
}

#ifndef SLOW_MIXER
#define SLOW_MIXER 1
#endif
extern "C" void kernel_launch(void* const* d_in, const int* in_sizes, int n_in, void* d_out, int out_size, void* d_ws, size_t ws_size, hipStream_t stream) {
    static int grid = 0;
    if (grid == 0) {
        if (n_in != 15 || out_size != M * D || ws_size < WS_END) { fprintf(stderr, "kernel_launch: unexpected shapes (n_in %d out %d ws %zu, need %zu)\n", n_in, out_size, ws_size, (size_t)WS_END); grid = -1; return; }
        int dev = 0, cus = 0, per_cu = 0;
        if (hipGetDevice(&dev) != hipSuccess || hipDeviceGetAttribute(&cus, hipDeviceAttributeMultiprocessorCount, dev) != hipSuccess) { grid = -1; return; }
        if (hipFuncSetAttribute((const void*)mega, hipFuncAttributeMaxDynamicSharedMemorySize, LDS_BYTES) != hipSuccess) { fprintf(stderr, "kernel_launch: hipFuncSetAttribute failed\n"); grid = -1; return; }
        if (hipOccupancyMaxActiveBlocksPerMultiprocessor(&per_cu, (const void*)mega, NWAVES * 64, LDS_BYTES) != hipSuccess || per_cu < 1) { fprintf(stderr, "kernel_launch: occupancy query says %d\n", per_cu); }
        (void)hipGetLastError();
        grid = cus;
    }
    if (grid < 0) return;
    unsigned char* ws = (unsigned char*)d_ws;
    (void)hipMemsetAsync(ws + WS_CTL, 0, CTL_BYTES, stream);
    Args a{};
    for (int i = 0; i < 15; ++i) a.in[i] = (const float*)d_in[i];
    a.out = (float*)d_out; a.ws = ws;
    int li = 0;
#define LAUNCH(lo_, hi_) do { a.ph_lo = (lo_); a.ph_hi = (hi_); a.li = li++; hipLaunchKernelGGL(mega, dim3(grid), dim3(NWAVES * 64), LDS_BYTES, stream, a); } while (0)
#if SLOW_MIXER
    int lo = 0;
    for (int l = 0; l < DEPTH; ++l) {
        const int pb = 1 + l * PH_PER_LAYER;
        LAUNCH(lo, pb + 3);
        hipLaunchKernelGGL(k_slow_retention, dim3(BATCH * RH), dim3(128), 0, stream, (bf16_t*)(ws + WS_QR), (const bf16_t*)(ws + WS_KR), (const bf16_t*)(ws + WS_VR), (const bf16_t*)(ws + WS_GR), (const float*)d_in[IN_RETNORM] + l * 512);
        hipLaunchKernelGGL(k_cumsum, dim3(BATCH * FH), dim3(64), 0, stream, (const float*)(ws + WS_LFT), (float*)(ws + WS_CUM));
        hipLaunchKernelGGL(k_slow_fox, dim3(SEQ / 64, BATCH * FH), dim3(64), 0, stream, (bf16_t*)(ws + WS_FQ), (const bf16_t*)(ws + WS_FK), (const bf16_t*)(ws + WS_FV), (const float*)(ws + WS_CUM));
        lo = pb + 6;
    }
    LAUNCH(lo, N_PHASES);
#else
    LAUNCH(0, N_PHASES);
#endif
}
```

```cpp
#include <hip/hip_runtime.h>
#include <cstdio>
#include <cstdint>

typedef unsigned short bf16_t;

constexpr int D = 1024, BATCH = 4, SEQ = 4096, DEPTH = 4, M = BATCH * SEQ;
constexpr int RH = 4, RDK = 128, FH = 8, FD = 64, DFF = 2816, IN_COLS = 5640;
constexpr int NIN = 5888;
constexpr float EPS = 1e-6f;
constexpr int C_RQ = 0, C_RK = 512, C_RV = 1024, C_RG = 1536, C_FQ = 2048, C_FK = 2560, C_FV = 3072, C_FF = 3584, C_GR = 3592, C_GF = 4616;
constexpr float FOX_C2 = 0.125f * 1.4426950408889634f;
constexpr float RET_KSCALE = 0.08838834764831845f;

constexpr size_t MiB = 1u << 20;
constexpr size_t WS_CTL = 0, CTL_BYTES = 1 * MiB;
constexpr size_t WS_PART = 1 * MiB;
constexpr size_t WS_COS = 2 * MiB, WS_SIN = 3 * MiB;
constexpr size_t WS_LFT = 4 * MiB;
constexpr size_t WS_CUM = 4 * MiB + 512 * 1024;
constexpr size_t WS_XB = 8 * MiB;
constexpr size_t WS_KVS = 8 * MiB;
constexpr size_t WS_QR = 40 * MiB, WS_KR = 56 * MiB, WS_VR = 72 * MiB, WS_GR = 88 * MiB, WS_FQ = 104 * MiB, WS_FK = 120 * MiB, WS_FV = 136 * MiB;
constexpr size_t WS_GATER = 152 * MiB, WS_GATEF = 184 * MiB;
constexpr size_t WS_H = 40 * MiB;
constexpr size_t WS_MERGED = 56 * MiB;
constexpr size_t WS_T = 120 * MiB;
constexpr size_t WS_W = 216 * MiB;
constexpr size_t WO_1IN = 0, WO_1OUT = 11 * MiB, WO_IN = WO_1OUT + 5632 * 1024, WO_OR = WO_IN + (size_t)NIN * 2048, WO_OF = WO_OR + MiB, WO_OUT = WO_OF + MiB,
                 WO_2IN = WO_OUT + 2 * MiB, WO_2OUT = WO_2IN + 11 * MiB, W_LAYER = WO_2OUT + 5632 * 1024;
constexpr size_t WS_END = WS_W + DEPTH * W_LAYER;
static_assert(W_LAYER == 48 * MiB + 512 * 1024, "weights per layer");

constexpr int CW_BAR = 4096;

#define GAS __attribute__((address_space(1)))
#define LAS __attribute__((address_space(3)))
__device__ __forceinline__ float bf2f(bf16_t v) { return __uint_as_float((unsigned)v << 16); }
__device__ __forceinline__ bf16_t f2bf(float f) { unsigned u = __float_as_uint(f); return (bf16_t)((u + 0x7fffu + ((u >> 16) & 1u)) >> 16); }
__device__ __forceinline__ unsigned pk2(float lo, float hi) { return (unsigned)f2bf(lo) | ((unsigned)f2bf(hi) << 16); }
__device__ __forceinline__ float silu_f(float v) { return v / (1.f + __expf(-v)); }
__device__ __forceinline__ float sigmoid_f(float v) { return 1.f / (1.f + __expf(-v)); }
__device__ __forceinline__ float logsigmoid_f(float z) { return z >= 0.f ? -log1pf(expf(-z)) : z - log1pf(expf(z)); }
__device__ __forceinline__ float wave_sum(float v) {
#pragma unroll
    for (int o = 1; o < 64; o <<= 1) v += __shfl_xor(v, o);
    return v;
}
namespace pg8 {
#define PG8_LAS __attribute__((address_space(3)))
typedef unsigned short bf16_t;
typedef short bf16x8 __attribute__((ext_vector_type(8)));
typedef float f32x4 __attribute__((ext_vector_type(4)));
typedef unsigned u32x4 __attribute__((ext_vector_type(4)));
constexpr int BM = 256, BK = 64, HALF = 128, HTB = HALF * BK * 2  , STAGE_BYTES = 8 * HTB, NXCD = 8, WGM = 8;

__host__ __device__ __forceinline__ int lds_byte(int r, int c) { const int st = (r >> 4) * 2 + (c >> 5), rr = r & 15, cc = c & 31, ob = rr * 64 + cc * 2; return st * 1024 + (ob ^ (((ob >> 9) & 1) << 5)); }
__host__ __device__ __forceinline__ void stage_rc(int b, int& R, int& C) { const int st = b / 1024, sb = b % 1024, swz = sb ^ (((sb >> 9) & 1) << 5); R = (st >> 1) * 16 + swz / 64; C = (st & 1) * 32 + (swz % 64) / 2; }
__host__ __device__ __forceinline__ int perm32(int rho) { const int n = rho >> 4, i = rho & 15; return 8 * (i >> 2) + 4 * n + (i & 3); }

struct Unit { int pm, pn; };
struct Gemm { const bf16_t* A; const bf16_t* Bt; int M, N, K; };

struct StaticOrder {
    int nM, nN, nwg, G, c;
    __host__ __device__ void init(int M, int N, int G_, int c_) { nM = M / BM; nN = N / BM; nwg = nM * nN; G = G_; c = c_; }
    __host__ __device__ bool next(int i, Unit& u) const {
        const long L = (long)i * G + c; if (L >= nwg) return false;
        int wgid = (int)L; { const int q = nwg / NXCD, r = nwg % NXCD, xcd = wgid % NXCD, off = wgid / NXCD; wgid = (xcd < r ? xcd * (q + 1) : r * (q + 1) + (xcd - r) * q) + off; }
        const int nig = WGM * nN, gid = wgid / nig, fm = gid * WGM, gsz = (nM - fm) < WGM ? (nM - fm) : WGM;
        u.pm = fm + ((wgid % nig) % gsz); u.pn = (wgid % nig) / gsz; return true;
    }
    __device__ __forceinline__ void a_ready(const Unit&) const {}
    __device__ __forceinline__ void done(const Unit&) const {}
};
template <class Epi, class Sched, bool ALIGN_EPI = false, bool SP2 = false>
__device__ __forceinline__ void gemm_phase(PG8_LAS unsigned char* lds, const Gemm g, const Sched& S, const Epi& E) {
    int tid_ = threadIdx.x; asm volatile("" : "+v"(tid_));
    const int tid = tid_, wid = __builtin_amdgcn_readfirstlane(tid >> 6), lane = tid & 63, wr = wid >> 2, wc = wid & 3, fr = lane & 15, fq = lane >> 4;
    const int K = g.K, nt = K / BK;
    unsigned voffA[2], voffB[2];
#pragma unroll
    for (int i = 0; i < 2; ++i) { int R, C; stage_rc(tid * 16 + i * 8192, R, C); const int Rb = Epi::PERM ? ((R & ~31) + perm32(R & 31)) : R;
        voffA[i] = (unsigned)(R * K + C) * 2u; voffB[i] = (unsigned)(Rb * K + C) * 2u; }
    const size_t kstep = (size_t)(BK * 2);
    const size_t hstep = (size_t)HALF * K * 2;
    const size_t tstep = 2 * hstep;
    const unsigned ldsw = (unsigned)wid * 1024u;
    const int aoff = lds_byte(wr * 64 + fr, fq * 8), boff = lds_byte(wc * 32 + fr, fq * 8);
#define PG8_SA(b, h) (((b) * 2 + (h)) * HTB)
#define PG8_SB(b, h) ((4 + (b) * 2 + (h)) * HTB)
#define PG8_STAGE(bufoff, gbase, voff) do { _Pragma("unroll") for (int _i = 0; _i < 2; ++_i) \
        __builtin_amdgcn_global_load_lds((const unsigned*)((const char*)(gbase) + (voff)[_i]), (PG8_LAS unsigned*)(lds + (bufoff) + ldsw + _i * 8192), 16, 0, 0); } while (0)
#define PG8_LDA(dst, b, h) do { _Pragma("unroll") for (int m = 0; m < 4; ++m) _Pragma("unroll") for (int k = 0; k < 2; ++k) dst[m][k] = *(const PG8_LAS bf16x8*)(lds + PG8_SA(b, h) + aoff + m * 2048 + k * 1024); } while (0)
#define PG8_LDB(dst, b, h) do { _Pragma("unroll") for (int n = 0; n < 2; ++n) _Pragma("unroll") for (int k = 0; k < 2; ++k) dst[n][k] = *(const PG8_LAS bf16x8*)(lds + PG8_SB(b, h) + boff + n * 2048 + k * 1024); } while (0)
#define PG8_MMA(ai, bj, At, Bt) do { __builtin_amdgcn_s_setprio(1); _Pragma("unroll") for (int m = 0; m < 4; ++m) _Pragma("unroll") for (int n = 0; n < 2; ++n) _Pragma("unroll") for (int k = 0; k < 2; ++k) \
        acc[ai][bj][m][n] = __builtin_amdgcn_mfma_f32_16x16x32_bf16(Bt[n][k], At[m][k], acc[ai][bj][m][n], 0, 0, 0); __builtin_amdgcn_s_setprio(0); } while (0)
#define PG8_WAIT_V(n) asm volatile("s_waitcnt vmcnt(" #n ")" ::: "memory")
#define PG8_WAIT_L(n) asm volatile("s_waitcnt lgkmcnt(" #n ")" ::: "memory")
#define PG8_BAR __builtin_amdgcn_s_barrier()
#define PG8_SCHED __builtin_amdgcn_sched_barrier(0)
    Unit cur, nxt; int ui = 0;
    if (!S.next(0, cur)) return;
    f32x4 acc[2][2][4][2];
#pragma unroll
    for (int a = 0; a < 2; ++a)
#pragma unroll
        for (int b = 0; b < 2; ++b)
#pragma unroll
            for (int m = 0; m < 4; ++m)
#pragma unroll
                for (int n = 0; n < 2; ++n) acc[a][b][m][n] = (f32x4){0.f, 0.f, 0.f, 0.f};
    bf16x8 At[4][2], B0[2][2], B1[2][2];
    const char* cA = (const char*)g.A + (size_t)cur.pm * tstep; const char* cB = (const char*)g.Bt + (size_t)cur.pn * tstep;
    S.a_ready(cur);
    if constexpr (SP2) {
        PG8_STAGE(PG8_SB(0, 0), cB, voffB); PG8_STAGE(PG8_SB(0, 1), cB + hstep, voffB); PG8_STAGE(PG8_SA(0, 0), cA, voffA); PG8_STAGE(PG8_SA(0, 1), cA + hstep, voffA);
        if (wr == 1) PG8_BAR;
        PG8_WAIT_V(2); PG8_BAR;
        PG8_STAGE(PG8_SB(1, 0), cB + kstep, voffB); PG8_STAGE(PG8_SA(1, 0), cA + kstep, voffA); PG8_STAGE(PG8_SB(1, 1), cB + hstep + kstep, voffB);
        PG8_WAIT_V(6); PG8_BAR;
    } else {
        PG8_STAGE(PG8_SB(0, 0), cB, voffB); PG8_STAGE(PG8_SA(0, 0), cA, voffA); PG8_STAGE(PG8_SB(0, 1), cB + hstep, voffB); PG8_STAGE(PG8_SA(0, 1), cA + hstep, voffA);
        if (wr == 1) PG8_BAR;
        PG8_WAIT_V(4); PG8_BAR;
        PG8_STAGE(PG8_SB(1, 0), cB + kstep, voffB); PG8_STAGE(PG8_SA(1, 0), cA + kstep, voffA); PG8_STAGE(PG8_SB(1, 1), cB + hstep + kstep, voffB);
        PG8_WAIT_V(6); PG8_BAR;
    }
    for (;;) {
        const bool has_next = S.next(ui + 1, nxt);
        const char* nA = has_next ? (const char*)g.A + (size_t)nxt.pm * tstep : cA; const char* nB = has_next ? (const char*)g.Bt + (size_t)nxt.pn * tstep : cB;
        for (int t = 0; t < nt; t += 2) {
            const bool last = (t == nt - 2);
            const char* a1 = cA + (size_t)(t + 1) * kstep;
            const char* a2 = last ? nA : cA + (size_t)(t + 2) * kstep; const char* b2 = last ? nB : cB + (size_t)(t + 2) * kstep;
            const char* a3 = a2 + kstep; const char* b3 = b2 + kstep;
            if (last && has_next) S.a_ready(nxt);
            if constexpr (SP2) {
            PG8_LDB(B0, 0, 0); PG8_LDB(B1, 0, 1); PG8_SCHED; PG8_LDA(At, 0, 0); PG8_STAGE(PG8_SA(1, 1), a1 + hstep, voffA);
            PG8_WAIT_V(8); PG8_WAIT_L(0); PG8_BAR; PG8_MMA(0, 0, At, B0); PG8_MMA(0, 1, At, B1); PG8_BAR; PG8_SCHED;
            PG8_LDA(At, 0, 1); PG8_STAGE(PG8_SB(0, 0), b2, voffB); PG8_STAGE(PG8_SB(0, 1), b2 + hstep, voffB); PG8_STAGE(PG8_SA(0, 0), a2, voffA);
            PG8_WAIT_V(8); PG8_WAIT_L(0); PG8_BAR; PG8_MMA(1, 0, At, B0); PG8_MMA(1, 1, At, B1); PG8_BAR; PG8_SCHED;
            PG8_LDB(B0, 1, 0); PG8_LDB(B1, 1, 1); PG8_SCHED; PG8_LDA(At, 1, 0); PG8_STAGE(PG8_SA(0, 1), a2 + hstep, voffA);
            PG8_WAIT_V(8); PG8_WAIT_L(0); PG8_BAR; PG8_MMA(0, 0, At, B0); PG8_MMA(0, 1, At, B1); PG8_BAR; PG8_SCHED;
            PG8_LDA(At, 1, 1); PG8_STAGE(PG8_SB(1, 0), b3, voffB); PG8_STAGE(PG8_SB(1, 1), b3 + hstep, voffB); PG8_STAGE(PG8_SA(1, 0), a3, voffA);
            PG8_WAIT_V(8); PG8_WAIT_L(0); PG8_BAR; PG8_MMA(1, 0, At, B0); PG8_MMA(1, 1, At, B1); PG8_BAR; PG8_SCHED;
            } else {
            PG8_LDB(B0, 0, 0); PG8_SCHED; PG8_LDA(At, 0, 0); PG8_STAGE(PG8_SA(1, 1), a1 + hstep, voffA);
            PG8_WAIT_L(8); PG8_BAR; PG8_WAIT_L(0); PG8_MMA(0, 0, At, B0); PG8_BAR; PG8_SCHED;
            PG8_LDB(B1, 0, 1); PG8_STAGE(PG8_SB(0, 0), b2, voffB);
            PG8_BAR; PG8_WAIT_L(0); PG8_MMA(0, 1, At, B1); PG8_BAR;
            PG8_LDA(At, 0, 1); PG8_STAGE(PG8_SA(0, 0), a2, voffA);
            PG8_BAR; PG8_WAIT_L(0); PG8_MMA(1, 0, At, B0); PG8_BAR; PG8_SCHED;
            PG8_STAGE(PG8_SB(0, 1), b2 + hstep, voffB);
            PG8_WAIT_V(6); PG8_BAR; PG8_MMA(1, 1, At, B1); PG8_BAR;
            PG8_LDB(B0, 1, 0); PG8_SCHED; PG8_LDA(At, 1, 0); PG8_STAGE(PG8_SA(0, 1), a2 + hstep, voffA);
            PG8_WAIT_L(8); PG8_BAR; PG8_WAIT_L(0); PG8_MMA(0, 0, At, B0); PG8_BAR; PG8_SCHED;
            PG8_LDB(B1, 1, 1); PG8_STAGE(PG8_SB(1, 0), b3, voffB);
            PG8_BAR; PG8_WAIT_L(0); PG8_MMA(0, 1, At, B1); PG8_BAR;
            PG8_LDA(At, 1, 1); PG8_STAGE(PG8_SA(1, 0), a3, voffA);
            PG8_BAR; PG8_WAIT_L(0); PG8_MMA(1, 0, At, B0); PG8_BAR; PG8_SCHED;
            PG8_STAGE(PG8_SB(1, 1), b3 + hstep, voffB);
            PG8_WAIT_V(6); PG8_BAR; PG8_MMA(1, 1, At, B1); PG8_BAR;
            }
        }
        if constexpr (ALIGN_EPI) { if (wr == 0) PG8_BAR; }
        if constexpr (!Epi::AFTER_DRAIN) { E(acc, cur, wr, wc, fr, fq); S.done(cur); }
        if (!has_next) break;
#pragma unroll
        for (int a = 0; a < 2; ++a)
#pragma unroll
            for (int b = 0; b < 2; ++b)
#pragma unroll
                for (int m = 0; m < 4; ++m)
#pragma unroll
                    for (int n = 0; n < 2; ++n) acc[a][b][m][n] = (f32x4){0.f, 0.f, 0.f, 0.f};
        cur = nxt; cA = nA; cB = nB; ++ui;
        if constexpr (ALIGN_EPI) { if (wr == 1) PG8_BAR; }
    }
    PG8_WAIT_V(0);
    if constexpr (!ALIGN_EPI) { if (wr == 0) PG8_BAR; }
    PG8_BAR;
    if constexpr (Epi::AFTER_DRAIN) { E.fused(acc, cur, wr, wc, fr, fq, lds, wid, lane); S.done(cur); }
#undef PG8_SA
#undef PG8_SB
#undef PG8_STAGE
#undef PG8_LDA
#undef PG8_LDB
#undef PG8_MMA
#undef PG8_WAIT_V
#undef PG8_WAIT_L
#undef PG8_BAR
#undef PG8_SCHED
}
}
namespace pg8 {
__device__ __forceinline__ unsigned cvt_pk_bf16(float lo, float hi) { unsigned r; asm volatile("v_cvt_pk_bf16_f32 %0, %1, %2" : "=v"(r) : "v"(lo), "v"(hi)); return r; }
__device__ __forceinline__ u32x4 pack8(const f32x4 a, const f32x4 b) { u32x4 w; w.x = cvt_pk_bf16(a[0], a[1]); w.y = cvt_pk_bf16(a[2], a[3]); w.z = cvt_pk_bf16(b[0], b[1]); w.w = cvt_pk_bf16(b[2], b[3]); return w; }
__device__ __forceinline__ f32x4 unpack_lo(const u32x4 w) { return (f32x4){__uint_as_float(w.x << 16), __uint_as_float(w.x & 0xffff0000u), __uint_as_float(w.y << 16), __uint_as_float(w.y & 0xffff0000u)}; }
__device__ __forceinline__ f32x4 unpack_hi(const u32x4 w) { return (f32x4){__uint_as_float(w.z << 16), __uint_as_float(w.z & 0xffff0000u), __uint_as_float(w.w << 16), __uint_as_float(w.w & 0xffff0000u)}; }
__device__ __forceinline__ float fast_sigmoid(float v) { return __builtin_amdgcn_rcpf(1.f + __builtin_amdgcn_exp2f(-1.4426950408889634f * v)); }
__device__ __forceinline__ f32x4 sigmoid4(const f32x4 v) { return (f32x4){fast_sigmoid(v[0]), fast_sigmoid(v[1]), fast_sigmoid(v[2]), fast_sigmoid(v[3])}; }
__device__ __forceinline__ f32x4 silu4(const f32x4 v) { return v * sigmoid4(v); }
__device__ __forceinline__ float rstd_row(const float* part, int row, int fq) {
    const f32x4 p = *(const f32x4*)(part + (size_t)row * 16 + 4 * fq);
    float s = (p[0] + p[1]) + (p[2] + p[3]);
    s += __shfl_xor(s, 16); s += __shfl_xor(s, 32);
    return rsqrtf(s * (1.f / 1024.f) + 1e-6f);
}

struct EpiSwiglu {
    static constexpr bool PERM = true, AFTER_DRAIN = false;
    bf16_t* H; const float* part;
    __device__ __forceinline__ void operator()(const f32x4 (&acc)[2][2][4][2], const Unit& u, int wr, int wc, int fr, int fq) const {
        const int row0 = u.pm * BM + wr * 64 + fr, hcol = u.pn * 128 + wc * 32 + 8 * fq;
#pragma unroll
        for (int ai = 0; ai < 2; ++ai)
#pragma unroll
            for (int m = 0; m < 4; ++m) {
                const int row = row0 + ai * HALF + m * 16; const float r = rstd_row(part, row, fq);
                const f32x4 h0 = silu4(acc[ai][0][m][0] * r) * (acc[ai][1][m][0] * r), h1 = silu4(acc[ai][0][m][1] * r) * (acc[ai][1][m][1] * r);
                *(u32x4*)(H + (size_t)row * 2816 + hcol) = pack8(h0, h1);
            }
    }
};
struct EpiResid {
    static constexpr bool PERM = true, AFTER_DRAIN = false;
    float* x; bf16_t* xb; float* part; float alpha;
    __device__ __forceinline__ void operator()(const f32x4 (&acc)[2][2][4][2], const Unit& u, int wr, int wc, int fr, int fq) const {
        const int row0 = u.pm * BM + wr * 64 + fr, col0 = u.pn * BM + wc * 32 + 8 * fq;
#pragma unroll
        for (int ai = 0; ai < 2; ++ai)
#pragma unroll
            for (int m = 0; m < 4; ++m) {
                const int row = row0 + ai * HALF + m * 16; float ss = 0.f;
#pragma unroll
                for (int bj = 0; bj < 2; ++bj) {
                    float* xp = x + (size_t)row * 1024 + col0 + bj * HALF;
                    f32x4 v0 = *(const f32x4*)xp, v1 = *(const f32x4*)(xp + 4);
                    v0 += acc[ai][bj][m][0] * alpha; v1 += acc[ai][bj][m][1] * alpha;
                    *(f32x4*)xp = v0; *(f32x4*)(xp + 4) = v1;
                    ss += (v0[0] * v0[0] + v0[1] * v0[1]) + (v0[2] * v0[2] + v0[3] * v0[3]) + (v1[0] * v1[0] + v1[1] * v1[1]) + (v1[2] * v1[2] + v1[3] * v1[3]);
                    *(u32x4*)(xb + (size_t)row * 1024 + col0 + bj * HALF) = pack8(v0, v1);
                }
                ss += __shfl_xor(ss, 16); ss += __shfl_xor(ss, 32);
                if (fq == 0) part[(size_t)row * 16 + u.pn * 4 + wc] = ss;
            }
    }
};
struct EpiInproj {
    static constexpr bool PERM = true, AFTER_DRAIN = false;
    const float* part; const float* cs; const float* sn; const float* bforget; unsigned char* ws; float* lft;
    __device__ __forceinline__ void operator()(const f32x4 (&acc)[2][2][4][2], const Unit& u, int wr, int wc, int fr, int fq) const {
        const int row0 = u.pm * BM + wr * 64 + fr, pn = u.pn;
        if (pn < 4) {
            bf16_t* dst = (bf16_t*)(ws + (pn < 2 ? WS_QR : WS_KR)); const float scale = pn < 2 ? 1.f : RET_KSCALE;
            const int head = 2 * (pn & 1) + (wc >> 1), i0 = 32 * (wc & 1) + 8 * fq;
#pragma unroll
            for (int ai = 0; ai < 2; ++ai)
#pragma unroll
                for (int m = 0; m < 4; ++m) {
                    const int row = row0 + ai * HALF + m * 16, s = row & (SEQ - 1); const float r = rstd_row(part, row, fq) * scale;
                    const f32x4 c0 = *(const f32x4*)(cs + s * 64 + i0), c1 = *(const f32x4*)(cs + s * 64 + i0 + 4), s0 = *(const f32x4*)(sn + s * 64 + i0), s1 = *(const f32x4*)(sn + s * 64 + i0 + 4);
                    const f32x4 a0 = acc[ai][0][m][0] * r, a1 = acc[ai][0][m][1] * r, b0 = acc[ai][1][m][0] * r, b1 = acc[ai][1][m][1] * r;
                    bf16_t* o = dst + (size_t)row * 512 + head * 128 + i0;
                    *(u32x4*)o = pack8(a0 * c0 - b0 * s0, a1 * c1 - b1 * s1);
                    *(u32x4*)(o + 64) = pack8(a0 * s0 + b0 * c0, a1 * s1 + b1 * c1);
                }
        } else if (pn < 22) {
            const int grp = pn < 14 ? (pn - 4) >> 1 : (pn < 18 ? 5 : 6);
            const size_t off = grp == 0 ? WS_VR : grp == 1 ? WS_GR : grp == 2 ? WS_FQ : grp == 3 ? WS_FK : grp == 4 ? WS_FV : grp == 5 ? WS_GATER : WS_GATEF;
            const int ldd = grp < 5 ? 512 : 1024, colb = grp < 5 ? 256 * (pn & 1) : 256 * ((pn - 14) & 3), act = grp == 1 ? 1 : grp >= 5 ? 2 : 0;
            const float scale = grp == 2 ? FOX_C2 : 1.f;
            bf16_t* dst = (bf16_t*)(ws + off) + colb + wc * 32 + 8 * fq;
#pragma unroll
            for (int ai = 0; ai < 2; ++ai)
#pragma unroll
                for (int m = 0; m < 4; ++m) {
                    const int row = row0 + ai * HALF + m * 16; const float r = rstd_row(part, row, fq);
#pragma unroll
                    for (int bj = 0; bj < 2; ++bj) {
                        f32x4 v0 = acc[ai][bj][m][0] * r, v1 = acc[ai][bj][m][1] * r;
                        if (act == 1) { v0 = silu4(v0); v1 = silu4(v1); } else if (act == 2) { v0 = sigmoid4(v0); v1 = sigmoid4(v1); }
                        *(u32x4*)(dst + (size_t)row * ldd + bj * HALF) = pack8(v0 * scale, v1 * scale);
                    }
                }
        } else {
#pragma unroll
            for (int ai = 0; ai < 2; ++ai)
#pragma unroll
                for (int m = 0; m < 4; ++m) {
                    const int row = row0 + ai * HALF + m * 16; const float r = rstd_row(part, row, fq);
                    if (wc == 0 && fq == 0) {
                        const int b = row >> 12, s = row & (SEQ - 1);
#pragma unroll
                        for (int n = 0; n < 2; ++n)
#pragma unroll
                            for (int e = 0; e < 4; ++e) { const int hd = 4 * n + e; lft[(size_t)(b * FH + hd) * SEQ + s] = logsigmoid_f(acc[ai][0][m][n][e] * r + bforget[hd]); }
                    }
                }
        }
    }
};
struct EpiGateT {
    static constexpr bool PERM = true, AFTER_DRAIN = false;
    const bf16_t* gate; bf16_t* T;
    __device__ __forceinline__ void operator()(const f32x4 (&acc)[2][2][4][2], const Unit& u, int wr, int wc, int fr, int fq) const {
        const int row0 = u.pm * BM + wr * 64 + fr, col0 = u.pn * BM + wc * 32 + 8 * fq;
#pragma unroll
        for (int ai = 0; ai < 2; ++ai)
#pragma unroll
            for (int m = 0; m < 4; ++m)
#pragma unroll
                for (int bj = 0; bj < 2; ++bj) {
                    const size_t o = (size_t)(row0 + ai * HALF + m * 16) * 1024 + col0 + bj * HALF;
                    const u32x4 g = *(const u32x4*)(gate + o);
                    *(u32x4*)(T + o) = pack8(unpack_lo(g) * acc[ai][bj][m][0], unpack_hi(g) * acc[ai][bj][m][1]);
                }
    }
};
struct EpiMergeF {
    static constexpr bool PERM = true, AFTER_DRAIN = false;
    const bf16_t* gate; const bf16_t* T; bf16_t* out;
    __device__ __forceinline__ void operator()(const f32x4 (&acc)[2][2][4][2], const Unit& u, int wr, int wc, int fr, int fq) const {
        const int row0 = u.pm * BM + wr * 64 + fr, col0 = u.pn * BM + wc * 32 + 8 * fq;
#pragma unroll
        for (int ai = 0; ai < 2; ++ai)
#pragma unroll
            for (int m = 0; m < 4; ++m)
#pragma unroll
                for (int bj = 0; bj < 2; ++bj) {
                    const size_t o = (size_t)(row0 + ai * HALF + m * 16) * 1024 + col0 + bj * HALF;
                    const u32x4 g = *(const u32x4*)(gate + o), t = *(const u32x4*)(T + o);
                    *(u32x4*)(out + o) = pack8(unpack_lo(t) + unpack_lo(g) * acc[ai][bj][m][0], unpack_hi(t) + unpack_hi(g) * acc[ai][bj][m][1]);
                }
    }
};
}
#include <hip/hip_bf16.h>
namespace fox {
using bf16=__hip_bfloat16;
using bf16x8=__attribute__((ext_vector_type(8)))short;
using s16x4=__attribute__((ext_vector_type(4)))short;
using f32x16=__attribute__((ext_vector_type(16)))float;
using u32x4=__attribute__((ext_vector_type(4)))unsigned;
constexpr int BATCH=4,NHEAD=8,SEQ=4096,D=64,DM=NHEAD*D;
constexpr int NW=8,QBLK=32,QB=QBLK*NW,KVBLK=64,NQB=SEQ/QB;
constexpr int ATTN_PITCH=DM, ATTN_UNIT_ROWS=QB;
__device__ __forceinline__ int crow(int r,int hi){return (r&3)+8*(r>>2)+4*hi;}
#define SBAR() __builtin_amdgcn_sched_barrier(0)
__device__ __forceinline__ void cmask(f32x16&p0,f32x16&p1,int jb,int qrel,int hi){
  const float NEG=-INFINITY; int kb=64*jb+4*hi;
  #pragma unroll
  for(int r=0;r<16;++r){int kv=kb+(r&3)+8*(r>>2); if(kv>qrel)p0[r]=NEG; if(kv+32>qrel)p1[r]=NEG;}
}

constexpr int NSLOT=3, SLOTB=8192;
constexpr int LDS_K=0, LDS_V=NSLOT*SLOTB, LDS_WS=2*NSLOT*SLOTB, LDS_OST=LDS_WS+NW*64*4, LDS_CUM=LDS_OST+NW*4096, LDS_BYTES=LDS_CUM+SEQ*4;
constexpr float C2=0.125f*1.4426950408889634f;
__device__ __forceinline__ void glds16(const void*gsrc,unsigned lds_dst){unsigned keep;
  asm volatile("s_mov_b32 %0, m0\n\ts_mov_b32 m0, %2\n\ts_nop 0\n\tglobal_load_lds_dwordx4 %1, off\n\ts_mov_b32 m0, %0":"=&s"(keep):"v"(gsrc),"s"(lds_dst):"memory");}
__device__ __forceinline__ float max3f(float a,float b,float c){float r;asm("v_max3_f32 %0, %1, %2, %3":"=v"(r):"v"(a),"v"(b),"v"(c));return r;}
__device__ __forceinline__ float max2f(float a,float b){float r;asm("v_max_f32_e32 %0, %1, %2":"=v"(r):"v"(a),"v"(b));return r;}
__device__ __forceinline__ float fadd_s(float a,float b){float r;asm("v_add_f32_e32 %0, %1, %2":"=v"(r):"v"(a),"v"(b));return r;}
__device__ __forceinline__ float fsub_s(float a,float b){float r;asm("v_sub_f32_e32 %0, %1, %2":"=v"(r):"v"(a),"v"(b));return r;}
typedef float f32x2_t __attribute__((ext_vector_type(2))); typedef __bf16 bf16x2_t __attribute__((ext_vector_type(2)));
__device__ __forceinline__ unsigned cvtpk_s(float lo,float hi){f32x2_t v={lo,hi};bf16x2_t b=__builtin_convertvector(v,bf16x2_t);return __builtin_bit_cast(unsigned,b);}
#define WAIT_BAR(N) asm volatile("s_waitcnt vmcnt(" #N ") lgkmcnt(0)\n\ts_barrier":::"memory")

__device__ __forceinline__ void qkt(f32x16&p0,f32x16&p1,const char*Kslot,const bf16x8*qr,const f32x16&negm,int r32,int hi){
  const char*kb=Kslot+hi*1024+r32*16;
  #pragma unroll
  for(int d0=0;d0<4;++d0){
    const bf16x8 b0=*reinterpret_cast<const bf16x8*>(kb+d0*2048);
    const bf16x8 b1=*reinterpret_cast<const bf16x8*>(kb+d0*2048+512);
    if(d0==0){p0=__builtin_amdgcn_mfma_f32_32x32x16_bf16(b0,qr[0],negm,0,0,0);p1=__builtin_amdgcn_mfma_f32_32x32x16_bf16(b1,qr[0],negm,0,0,0);}
    else{p0=__builtin_amdgcn_mfma_f32_32x32x16_bf16(b0,qr[d0],p0,0,0,0);p1=__builtin_amdgcn_mfma_f32_32x32x16_bf16(b1,qr[d0],p1,0,0,0);}}
}
typedef __attribute__((address_space(3))) const char* lds_cptr;
typedef short v4i16_t __attribute__((ext_vector_type(4)));
__device__ __forceinline__ void kload8(bf16x8*kf,lds_cptr kp){
  kf[0]=*(const __attribute__((address_space(3))) bf16x8*)(kp);      kf[1]=*(const __attribute__((address_space(3))) bf16x8*)(kp+512);
  kf[2]=*(const __attribute__((address_space(3))) bf16x8*)(kp+2048); kf[3]=*(const __attribute__((address_space(3))) bf16x8*)(kp+2560);
  kf[4]=*(const __attribute__((address_space(3))) bf16x8*)(kp+4096); kf[5]=*(const __attribute__((address_space(3))) bf16x8*)(kp+4608);
  kf[6]=*(const __attribute__((address_space(3))) bf16x8*)(kp+6144); kf[7]=*(const __attribute__((address_space(3))) bf16x8*)(kp+6656);
}
__device__ __forceinline__ void kload2(bf16x8*kf,lds_cptr kp,int j){ kf[2*j]=*(const __attribute__((address_space(3))) bf16x8*)(kp+j*2048); kf[2*j+1]=*(const __attribute__((address_space(3))) bf16x8*)(kp+j*2048+512); }
__device__ __forceinline__ s16x4 vtr(lds_cptr p){ return __builtin_bit_cast(s16x4,__builtin_amdgcn_ds_read_tr16_b64_v4i16((__attribute__((address_space(3))) v4i16_t*)p)); }
__device__ __forceinline__ float rowmax(const f32x16&p0,const f32x16&p1){
  float a=max3f(p0[0],p0[1],p1[0]),b=max3f(p0[2],p0[3],p1[1]);a=max3f(a,p1[2],p1[3]);
  #pragma unroll
  for(int r=4;r<16;r+=4){a=max3f(a,p0[r],p0[r+1]);b=max3f(b,p0[r+2],p0[r+3]);a=max3f(a,p1[r],p1[r+1]);b=max3f(b,p1[r+2],p1[r+3]);}
  const float m=max2f(a,b);
  auto rr=__builtin_amdgcn_permlane32_swap(__float_as_uint(m),__float_as_uint(m),false,false);
  return max2f(__uint_as_float(rr[0]),__uint_as_float(rr[1]));
}
__device__ __forceinline__ void pv(f32x16*o,int vb,bf16x8 pa0,bf16x8 pa1,bf16x8 pa2,bf16x8 pa3){
  #pragma unroll
  for(int d0=0;d0<2;++d0){s16x4 lo[4],hi[4];
    #pragma unroll
    for(int ks=0;ks<4;++ks){
      asm volatile("ds_read_b64_tr_b16 %0,%1 offset:%c2":"=&v"(lo[ks]):"v"(vb),"i"(d0*4096+ks*1024):"memory");
      asm volatile("ds_read_b64_tr_b16 %0,%1 offset:%c2":"=&v"(hi[ks]):"v"(vb),"i"(d0*4096+ks*1024+512):"memory");}
    asm volatile("s_waitcnt lgkmcnt(0)":::"memory");SBAR();
    #define PK(k) (bf16x8){lo[k][0],lo[k][1],lo[k][2],lo[k][3],hi[k][0],hi[k][1],hi[k][2],hi[k][3]}
    o[d0]=__builtin_amdgcn_mfma_f32_32x32x16_bf16(pa0,PK(0),o[d0],0,0,0);
    o[d0]=__builtin_amdgcn_mfma_f32_32x32x16_bf16(pa1,PK(1),o[d0],0,0,0);
    o[d0]=__builtin_amdgcn_mfma_f32_32x32x16_bf16(pa2,PK(2),o[d0],0,0,0);
    o[d0]=__builtin_amdgcn_mfma_f32_32x32x16_bf16(pa3,PK(3),o[d0],0,0,0);
    #undef PK
  }
}

#ifndef ATTN_STORE16
#define ATTN_STORE16(p,v) (*(u32x4*)(p)=(v))
#endif
template<int THRL> __device__ __forceinline__ void attn_unit(int b,int h,int qb,const bf16*Q,const bf16*__restrict__ K,const bf16*__restrict__ V,bf16*O,char*shm){
  int tid_=threadIdx.x; asm volatile("":"+v"(tid_)); const int tid=tid_,lane=tid&63,r32=lane&31,hi=lane>>5; const int wid=__builtin_amdgcn_readfirstlane(tid>>6);
  const long rowbase=(long)b*SEQ; const int q0=qb*QB;
  const bf16*Qw=Q+(rowbase+q0+wid*QBLK)*DM+h*D;
  const bf16*Kh=K+rowbase*DM+h*D,*Vh=V+rowbase*DM+h*D;
  const lds_cptr shm3=(lds_cptr)shm;
  const unsigned lds0=(unsigned)(uintptr_t)shm;
  float*wsf=(float*)(shm+LDS_WS)+wid*64;
  const bf16*ksrc=Kh+(long)lane*DM+wid*8;
  const bf16*vsrc=Vh+(long)(16*(wid&3)+(lane>>2))*DM+(wid>>2)*32+(lane&3)*8;
  const unsigned kdst=lds0+LDS_K+wid*1024, vdst=lds0+LDS_V+wid*1024;
  #define DMA_K(t,slot) glds16(ksrc+(long)(t)*KVBLK*DM,(unsigned)__builtin_amdgcn_readfirstlane(kdst+(slot)))
  #define DMA_V(t,slot) glds16(vsrc+(long)(t)*KVBLK*DM,(unsigned)__builtin_amdgcn_readfirstlane(vdst+(slot)))
  const int vb0=(int)(lds0+LDS_V)+((lane>>4)&1)*32+(lane&3)*8+(4*hi+((lane&15)>>2))*64;
  const char*Kbase=shm+LDS_K; bf16x8 kf[8];
  const lds_cptr kp0=shm3+LDS_K+hi*1024+r32*16; const lds_cptr vp0=shm3+LDS_V+((lane>>4)&1)*32+(lane&3)*8+(4*hi+((lane&15)>>2))*64;
  const int NT=(q0+QB)/KVBLK;
  DMA_K(0,0);DMA_V(0,0);DMA_K(1,SLOTB);
  bf16x8 qr[4];
  #pragma unroll
  for(int d0=0;d0<4;++d0)qr[d0]=*reinterpret_cast<const bf16x8*>(&Qw[(long)r32*DM+d0*16+hi*8]);
  typedef __attribute__((address_space(3))) const float* lds_cf; typedef float f32x4_t __attribute__((ext_vector_type(4)));
  const lds_cf cumL=(lds_cf)(shm3+LDS_CUM);
  const float cq=cumL[q0+wid*QBLK+r32];
  float mhat=0.f,l_reg=0.f;f32x16 o[2];o[0]=f32x16{};o[1]=f32x16{};f32x16 negm;
  #pragma unroll
  for(int r=0;r<16;++r)negm[r]=cq;
  asm volatile("":"+v"(negm));
  #define SUBC(P0,P1,t) do{ const lds_cf cb_=cumL+64*(t)+4*hi; _Pragma("unroll") for(int g_=0;g_<4;++g_){ const f32x4_t a_=*(const __attribute__((address_space(3))) f32x4_t*)(cb_+8*g_), b_=*(const __attribute__((address_space(3))) f32x4_t*)(cb_+32+8*g_); \
      _Pragma("unroll") for(int e_=0;e_<4;++e_){ P0[4*g_+e_]-=a_[e_]; P1[4*g_+e_]-=b_[e_]; } } }while(0)
  const int qrel=wid*QBLK+r32;
  #define CMASK(P0,P1,t) do{int jb_=(t)-(NT-4); if(jb_>=0)cmask(P0,P1,jb_,qrel,hi);}while(0)
  bool resc=false;
  #define START(P0,P1) do{ const float rm=rowmax(P0,P1); resc=false; \
    { const float dl=rm; mhat=fadd_s(mhat,dl); \
      _Pragma("unroll") for(int r=0;r<16;++r){P0[r]=fsub_s(P0[r],dl);P1[r]=fsub_s(P1[r],dl);} \
      _Pragma("unroll") for(int r=0;r<16;++r)negm[r]=cq-mhat; asm volatile("":"+v"(negm)); } \
    _Pragma("unroll") for(int r=0;r<16;++r)P0[r]=__builtin_amdgcn_exp2f(P0[r]); }while(0)
  #define RESC() do{ if(resc){ asm volatile("s_waitcnt lgkmcnt(0)":::"memory"); \
      _Pragma("unroll") for(int d_=0;d_<2;++d_) _Pragma("unroll") for(int r=0;r<16;++r)o[d_][r]*=wsf[crow(r,hi)]; } }while(0)
  f32x16 pA0,pA1,pB0,pB1;
  int sl_prev=0,sl_cur=0,sl_next=SLOTB;
  #define ROT() do{sl_prev=sl_cur;sl_cur=sl_next;sl_next=(sl_next==(NSLOT-1)*SLOTB)?0:sl_next+SLOTB;}while(0)
  DMA_K(2,2*SLOTB);
  WAIT_BAR(3);
  qkt(pA0,pA1,Kbase,qr,negm,r32,hi);asm volatile("s_nop 15\n\ts_nop 7":"+v"(pA0),"+v"(pA1));CMASK(pA0,pA1,0);SUBC(pA0,pA1,0);
  START(pA0,pA1);
  _Pragma("unroll") for(int r=0;r<16;++r)pA1[r]=__builtin_amdgcn_exp2f(pA1[r]);
  WAIT_BAR(0);
  DMA_K(3,0);DMA_V(1,SLOTB);
  ROT();
  kload8(kf,kp0+sl_cur);
  WAIT_BAR(2);
  s16x4 vlo[8],vhi[8]; u32x4 pw0,pw1,pw2,pw3;
  #define PKW(P,B) cvtpk_s(P[B],P[B+1])
  #define PAF(k) __builtin_bit_cast(bf16x8,pw##k)
  #define VFR(i) (bf16x8){vlo[i][0],vlo[i][1],vlo[i][2],vlo[i][3],vhi[i][0],vhi[i][1],vhi[i][2],vhi[i][3]}
  #define PIN(x) asm volatile("":"+v"(x))
  #define MX3(a,b,c) __builtin_fmaxf(__builtin_fmaxf((a),(b)),(c))
  #define GAPA(MF,A0,A1,A2,A3,W0,W1,PW) do{ MF; sacc+=A0; sacc+=A1; sacc+=A2; sacc+=A3; PIN(sacc); W0; W1; PIN(PW); SBAR(); }while(0)
  #define EX(v) __builtin_amdgcn_exp2f(v)
  #define GAPB(MF,X,B) do{ MF; X[B]=EX(X[B]); X[B+1]=EX(X[B+1]); X[B+2]=EX(X[B+2]); X[B+3]=EX(X[B+3]); PIN(X); SBAR(); }while(0)
  #define VRD(i) do{ vlo[i]=vtr(vp_+(((i)>>2)*4096+((i)&3)*1024)); vhi[i]=vtr(vp_+(((i)>>2)*4096+((i)&3)*1024+512)); }while(0)
  #define KRD(G,j) do{ if(G){ kload2(kf,kp0+sl_next,j); SBAR(); } }while(0)
  #define STEP(C0,C1,P0,P1,t,GK,GV,GL) do{ SBAR(); \
    const lds_cptr vp_=vp0+sl_prev; \
    VRD(0); SBAR(); float sacc=(P0[0]+P0[1]); \
    GAPA(C0=__builtin_amdgcn_mfma_f32_32x32x16_bf16(kf[0],qr[0],negm,0,0,0), P0[2],P0[3],P0[4],P0[5],     pw0[0]=PKW(P0,0), pw0[1]=PKW(P0,2), pw0); \
    VRD(4); SBAR(); GAPA(C1=__builtin_amdgcn_mfma_f32_32x32x16_bf16(kf[1],qr[0],negm,0,0,0), P0[6],P0[7],P0[8],P0[9],     pw0[2]=PKW(P0,4), pw0[3]=PKW(P0,6), pw0); \
    VRD(1); SBAR(); GAPA(C0=__builtin_amdgcn_mfma_f32_32x32x16_bf16(kf[2],qr[1],C0,0,0,0),   P0[10],P0[11],P0[12],P0[13], pw1[0]=PKW(P0,8), pw1[1]=PKW(P0,10), pw1); \
    VRD(5); SBAR(); GAPA(C1=__builtin_amdgcn_mfma_f32_32x32x16_bf16(kf[3],qr[1],C1,0,0,0),   P0[14],P0[15],P1[0],P1[1],   pw1[2]=PKW(P0,12),pw1[3]=PKW(P0,14), pw1); \
    VRD(2); SBAR(); GAPA(C0=__builtin_amdgcn_mfma_f32_32x32x16_bf16(kf[4],qr[2],C0,0,0,0),   P1[2],P1[3],P1[4],P1[5],     pw2[0]=PKW(P1,0), pw2[1]=PKW(P1,2), pw2); \
    VRD(6); SBAR(); GAPA(C1=__builtin_amdgcn_mfma_f32_32x32x16_bf16(kf[5],qr[2],C1,0,0,0),   P1[6],P1[7],P1[8],P1[9],     pw2[2]=PKW(P1,4), pw2[3]=PKW(P1,6), pw2); \
    VRD(3); SBAR(); GAPA(C0=__builtin_amdgcn_mfma_f32_32x32x16_bf16(kf[6],qr[3],C0,0,0,0),   P1[10],P1[11],P1[12],P1[13], pw3[0]=PKW(P1,8), pw3[1]=PKW(P1,10), pw3); \
    VRD(7); SBAR(); GAPA(C1=__builtin_amdgcn_mfma_f32_32x32x16_bf16(kf[7],qr[3],C1,0,0,0),   P1[14],P1[15],0.f,0.f,       pw3[2]=PKW(P1,12),pw3[3]=PKW(P1,14), pw3); \
    l_reg+=sacc; \
    if(GK){DMA_K((t)+3,sl_cur);} if(GV){DMA_V((t)+1,sl_next);} \
    CMASK(C0,C1,t); SUBC(C0,C1,t); \
    { float a=MX3(C0[0],C0[1],C1[0]),b=MX3(C0[2],C0[3],C1[1]); a=MX3(a,C1[2],C1[3]); \
      _Pragma("unroll") for(int r=4;r<16;r+=4){a=MX3(a,C0[r],C0[r+1]);b=MX3(b,C0[r+2],C0[r+3]);a=MX3(a,C1[r],C1[r+1]);b=MX3(b,C1[r+2],C1[r+3]);} \
      float rm=__builtin_fmaxf(a,b); { auto rr=__builtin_amdgcn_permlane32_swap(__float_as_uint(rm),__float_as_uint(rm),false,false); rm=__builtin_fmaxf(__uint_as_float(rr[0]),__uint_as_float(rr[1])); } \
      resc=false; \
      if(__builtin_expect(__any(rm>(float)THRL),0)){ const float dl=__builtin_fmaxf(rm,0.f); mhat+=dl; \
        _Pragma("unroll") for(int r=0;r<16;++r){C0[r]-=dl;C1[r]-=dl;} \
        _Pragma("unroll") for(int r=0;r<16;++r)negm[r]=cq-mhat; asm volatile("":"+v"(negm)); \
        const float f=__builtin_amdgcn_exp2f(-dl); l_reg*=f; if(hi==0)wsf[r32]=f; resc=true; } } \
    SBAR(); \
    GAPB(o[0]=__builtin_amdgcn_mfma_f32_32x32x16_bf16(PAF(0),VFR(0),o[0],0,0,0), C0,0); \
    GAPB(o[1]=__builtin_amdgcn_mfma_f32_32x32x16_bf16(PAF(0),VFR(4),o[1],0,0,0), C0,4); \
    KRD(GL,0); GAPB(o[0]=__builtin_amdgcn_mfma_f32_32x32x16_bf16(PAF(1),VFR(1),o[0],0,0,0), C0,8); \
    KRD(GL,1); GAPB(o[1]=__builtin_amdgcn_mfma_f32_32x32x16_bf16(PAF(1),VFR(5),o[1],0,0,0), C0,12); \
    KRD(GL,2); GAPB(o[0]=__builtin_amdgcn_mfma_f32_32x32x16_bf16(PAF(2),VFR(2),o[0],0,0,0), C1,0); \
    KRD(GL,3); GAPB(o[1]=__builtin_amdgcn_mfma_f32_32x32x16_bf16(PAF(2),VFR(6),o[1],0,0,0), C1,4); \
    GAPB(o[0]=__builtin_amdgcn_mfma_f32_32x32x16_bf16(PAF(3),VFR(3),o[0],0,0,0), C1,8); \
    GAPB(o[1]=__builtin_amdgcn_mfma_f32_32x32x16_bf16(PAF(3),VFR(7),o[1],0,0,0), C1,12); \
    }while(0)
  int t=1;
  #undef CMASK
  #define CMASK(P0,P1,t) do{}while(0)
  for(;t+5<NT;t+=2){
    STEP(pB0,pB1,pA0,pA1,t,true,true,true);     WAIT_BAR(2); RESC(); ROT();
    STEP(pA0,pA1,pB0,pB1,t+1,true,true,true);   WAIT_BAR(2); RESC(); ROT();
  }
  #undef CMASK
  #define CMASK(P0,P1,t) do{int jb_=(t)-(NT-4); if(jb_>=0)cmask(P0,P1,jb_,qrel,hi);}while(0)
  #define ENDW(tt) do{ if((tt)+3<NT){WAIT_BAR(2);} else if((tt)+2<NT){WAIT_BAR(1);} else {WAIT_BAR(0);} }while(0)
  for(;t+1<NT;t+=2){
    STEP(pB0,pB1,pA0,pA1,t,(t+3<NT),(t+1<NT),(t+1<NT));       ENDW(t);   RESC(); ROT();
    STEP(pA0,pA1,pB0,pB1,t+1,(t+4<NT),(t+2<NT),(t+2<NT));     ENDW(t+1); RESC(); ROT();
  }
  STEP(pB0,pB1,pA0,pA1,NT-1,false,false,false); RESC();
  { float sacc=pB0[0]+pB0[1]; _Pragma("unroll") for(int r=2;r<16;++r)sacc+=pB0[r]; _Pragma("unroll") for(int r=0;r<16;++r)sacc+=pB1[r]; l_reg+=sacc;
    pw0=(u32x4){PKW(pB0,0),PKW(pB0,2),PKW(pB0,4),PKW(pB0,6)};pw1=(u32x4){PKW(pB0,8),PKW(pB0,10),PKW(pB0,12),PKW(pB0,14)};pw2=(u32x4){PKW(pB1,0),PKW(pB1,2),PKW(pB1,4),PKW(pB1,6)};pw3=(u32x4){PKW(pB1,8),PKW(pB1,10),PKW(pB1,12),PKW(pB1,14)};
    SBAR(); pv(o,vb0+sl_cur,PAF(0),PAF(1),PAF(2),PAF(3)); }
  #undef PKW
  #undef PAF
  #undef VFR
  #undef PIN
  #undef MX3
  #undef GAPA
  #undef GAPB
  #undef EX
  #undef VRD
  #undef KRD
  #undef STEP
  #undef ENDW
  {auto rr=__builtin_amdgcn_permlane32_swap(__float_as_uint(l_reg),__float_as_uint(l_reg),false,false);l_reg=__uint_as_float(rr[0])+__uint_as_float(rr[1]);}
  if(hi==0)wsf[32+r32]=l_reg;asm volatile("s_waitcnt lgkmcnt(0)":::"memory");
  float rli[16];
  #pragma unroll
  for(int r=0;r<16;++r)rli[r]=__builtin_amdgcn_rcpf(wsf[32+crow(r,hi)]);
  bf16*Ow=O+(rowbase+q0+wid*QBLK)*DM+h*D;
  { bf16*stg=(bf16*)(shm+LDS_OST)+wid*2048;
    #pragma unroll
    for(int r=0;r<16;++r){const int orow=crow(r,hi);
      #pragma unroll
      for(int d0=0;d0<2;++d0)stg[orow*64+d0*32+r32]=__float2bfloat16(o[d0][r]*rli[r]);}
    asm volatile("s_waitcnt lgkmcnt(0)":::"memory");
    #pragma unroll
    for(int i=0;i<4;++i){const int row=i*8+(lane>>3),ch=lane&7; const u32x4 v=*(const u32x4*)(stg+row*64+ch*8); ATTN_STORE16(Ow+(long)row*DM+ch*8,v);} }
  asm volatile("s_waitcnt lgkmcnt(0)\n\ts_barrier":::"memory");
  #undef DMA_K
  #undef DMA_V
  #undef SUBC
  #undef CMASK
  #undef START
  #undef RESC
  #undef ROT
}
constexpr int ATTN_LDS_BYTES=LDS_BYTES;
struct AttnTensors { const bf16* Q; const bf16* K; const bf16* V; bf16* O; };
struct AttnUnit { int bh; int qb; };
struct StaticOrder {
  int vcu;
  __device__ __forceinline__ explicit StaticOrder(int grid,int block):vcu((block%8)*(grid/8)+block/8){}
  __device__ __forceinline__ bool next(int i,AttnUnit&u)const{ if(i>=2)return false; const int s=vcu&7; u.bh=vcu>>3; u.qb=(i==0)?s:15-s; return true; }
  __device__ __forceinline__ void a_ready(const AttnUnit&)const{}
  __device__ __forceinline__ void done(const AttnUnit&)const{}
};
template<class Sched,int THRL=8> __device__ __forceinline__ void attn_phase(char*lds,const AttnTensors&T,const float*lft,const Sched&S){
  AttnUnit u;
  if(!S.next(0,u))return;
  { int tid_=threadIdx.x; asm volatile("":"+v"(tid_)); const int tid=tid_,lane=tid&63,wid=tid>>6; typedef float f32x4_t __attribute__((ext_vector_type(4)));
    const float*src=lft+(long)u.bh*SEQ+tid*8; const f32x4_t a=*(const f32x4_t*)src,b=*(const f32x4_t*)(src+4);
    float v[8]={a[0],a[1],a[2],a[3],b[0],b[1],b[2],b[3]};
    #pragma unroll
    for(int j=1;j<8;++j)v[j]+=v[j-1];
    float sc=v[7];
    #pragma unroll
    for(int o=1;o<64;o<<=1){const float t=__shfl_up(sc,o);if(lane>=o)sc+=t;}
    __attribute__((address_space(3))) float*wsum=(__attribute__((address_space(3))) float*)(lds+LDS_WS);
    __attribute__((address_space(3))) float*cum=(__attribute__((address_space(3))) float*)(lds+LDS_CUM);
    if(lane==63)wsum[wid]=sc;
    __syncthreads();
    float off=sc-v[7];
    for(int w=0;w<wid;++w)off+=wsum[w];
    #pragma unroll
    for(int j=0;j<8;++j)cum[tid*8+j]=(off+v[j])*1.4426950408889634f;
    __syncthreads(); }
  for(int i=0;S.next(i,u);++i){ S.a_ready(u); attn_unit<THRL>(u.bh/NHEAD,u.bh%NHEAD,u.qb,T.Q,T.K,T.V,T.O,lds); S.done(u); }
}
#undef SBAR
#undef WAIT_BAR
}
namespace ret {
typedef short bf16x8 __attribute__((ext_vector_type(8)));
typedef short s16x4 __attribute__((ext_vector_type(4)));
typedef float f32x16 __attribute__((ext_vector_type(16)));
typedef float f32x4 __attribute__((ext_vector_type(4)));
typedef unsigned u32x4 __attribute__((ext_vector_type(4)));
typedef unsigned u32x2 __attribute__((ext_vector_type(2)));
typedef LAS const char* lds_cptr;
constexpr int CH = 128;
__device__ __forceinline__ int offb(int row, int ch) { return 256 * row + 16 * (ch ^ (((row & 3) << 2) | ((row >> 2) & 3))); }
__device__ __forceinline__ s16x4 vtr(lds_cptr p) { return __builtin_bit_cast(s16x4, __builtin_amdgcn_ds_read_tr16_b64_v4i16((LAS s16x4*)p)); }
__device__ __forceinline__ bf16x8 tr_frag(lds_cptr img, int Ra, int Rb, int C0blk, int lane) {
    const int q = (lane & 15) >> 2, p = lane & 3, c = ((C0blk + 16 * ((lane >> 4) & 1)) >> 3) + (p >> 1), hb = 8 * (p & 1);
    const s16x4 lo = vtr(img + offb(Ra + q, c) + hb), hi = vtr(img + offb(Rb + q, c) + hb);
    return (bf16x8){lo[0], lo[1], lo[2], lo[3], hi[0], hi[1], hi[2], hi[3]};
}
__device__ __forceinline__ unsigned cvt_pk(float lo, float hi) { unsigned r; asm volatile("v_cvt_pk_bf16_f32 %0, %1, %2" : "=v"(r) : "v"(lo), "v"(hi)); return r; }
__device__ __forceinline__ float lo16(unsigned w) { return __uint_as_float(w << 16); }
__device__ __forceinline__ float hi16(unsigned w) { return __uint_as_float(w & 0xffff0000u); }
__device__ __forceinline__ int crow(int r, int hi) { return (r & 3) + 8 * (r >> 2) + 4 * hi; }
__device__ __forceinline__ float log2_gamma(int h) { return log2f(1.f - exp2f(-5.f - (float)h)); }

template <bool SCALE> __device__ __forceinline__ void stage_bf16(LAS char* img, const bf16_t* src, int ld, int tid, float l2g) {
#pragma unroll
    for (int i = 0; i < 4; ++i) { const int c = tid + 512 * i, row = c >> 4, ch = c & 15;
        u32x4 v = *(const u32x4*)(src + (size_t)row * ld + ch * 8);
        if (SCALE) { const float z = exp2f(l2g * (float)(127 - row));
            v.x = cvt_pk(lo16(v.x) * z, hi16(v.x) * z); v.y = cvt_pk(lo16(v.y) * z, hi16(v.y) * z); v.z = cvt_pk(lo16(v.z) * z, hi16(v.z) * z); v.w = cvt_pk(lo16(v.w) * z, hi16(v.w) * z); }
        *(LAS u32x4*)(img + offb(row, ch)) = v; }
}
__device__ __forceinline__ void stage_f32(LAS char* img, const float* src, int tid) {
#pragma unroll
    for (int i = 0; i < 4; ++i) { const int c = tid + 512 * i, row = c >> 4, ch = c & 15;
        const f32x4 a = *(const f32x4*)(src + row * 128 + ch * 8), b = *(const f32x4*)(src + row * 128 + ch * 8 + 4);
        u32x4 v; v.x = cvt_pk(a[0], a[1]); v.y = cvt_pk(a[2], a[3]); v.z = cvt_pk(b[0], b[1]); v.w = cvt_pk(b[2], b[3]);
        *(LAS u32x4*)(img + offb(row, ch)) = v; }
}

__device__ __forceinline__ void retkv_unit(int bh, int n, const bf16_t* KR, const bf16_t* VR, float* KVS, LAS char* lds) {
    int tid_ = threadIdx.x; asm volatile("" : "+v"(tid_));
    const int tid = tid_, lane = tid & 63, wid = __builtin_amdgcn_readfirstlane(tid >> 6), hi = lane >> 5;
    const int b = bh >> 2, h = bh & 3; const float l2g = log2_gamma(h);
    const size_t rowbase = (size_t)(b * SEQ + n * CH) * 512 + h * 128;
    __syncthreads();
    stage_bf16<true>(lds, KR + rowbase, 512, tid, l2g);
    stage_bf16<false>(lds + 32768, VR + rowbase, 512, tid, 0.f);
    __syncthreads();
    const int mb = wid >> 1, nb0 = 2 * (wid & 1);
    f32x16 acc0 = {}, acc1 = {};
#pragma unroll
    for (int s = 0; s < 8; ++s) {
        const int Ra = 16 * s + 8 * hi;
        const bf16x8 A = tr_frag(lds, Ra, Ra + 4, 32 * mb, lane);
        const bf16x8 B0 = tr_frag(lds + 32768, Ra, Ra + 4, 32 * nb0, lane), B1 = tr_frag(lds + 32768, Ra, Ra + 4, 32 * nb0 + 32, lane);
        acc0 = __builtin_amdgcn_mfma_f32_32x32x16_bf16(A, B0, acc0, 0, 0, 0);
        acc1 = __builtin_amdgcn_mfma_f32_32x32x16_bf16(A, B1, acc1, 0, 0, 0);
    }
    float* out = KVS + ((size_t)bh * 32 + n) * 16384 + 32 * nb0 + (lane & 31);
#pragma unroll
    for (int r = 0; r < 16; ++r) { const int dk = 32 * mb + crow(r, hi); out[dk * 128] = acc0[r]; out[dk * 128 + 32] = acc1[r]; }
}

__device__ __forceinline__ void ret_scan(float* KVS, int gtid, int nthreads) {
    for (int idx = gtid; idx < 16 * 16384; idx += nthreads) {
        const int bh = idx >> 14, e = idx & 16383; const float gc = exp2f(128.f * log2_gamma(bh & 3));
        float* p = KVS + (size_t)bh * 32 * 16384 + e; float prev = 0.f;
#pragma unroll 1
        for (int n0 = 0; n0 < 32; n0 += 8) { float t[8];
#pragma unroll
            for (int j = 0; j < 8; ++j) t[j] = p[(size_t)(n0 + j) * 16384];
#pragma unroll
            for (int j = 0; j < 8; ++j) { p[(size_t)(n0 + j) * 16384] = prev; prev = gc * prev + t[j]; } }
    }
}

__device__ __forceinline__ void retout_unit(int bh, int cp, bf16_t* QR, const bf16_t* KR, const bf16_t* VR, const bf16_t* GR, const float* KVS, const float* retnorm, LAS char* lds) {
    int tid_ = threadIdx.x; asm volatile("" : "+v"(tid_));
    const int tid = tid_, lane = tid & 63, wid = __builtin_amdgcn_readfirstlane(tid >> 6), hi = lane >> 5, r32 = lane & 31;
    const int b = bh >> 2, h = bh & 3; const float l2g = log2_gamma(h);
    __syncthreads();
#pragma unroll
    for (int c = 0; c < 2; ++c) { const int n = 2 * cp + c;
        stage_bf16<false>(lds + c * 65536, VR + (size_t)(b * SEQ + n * CH) * 512 + h * 128, 512, tid, 0.f);
        stage_f32(lds + c * 65536 + 32768, KVS + ((size_t)bh * 32 + n) * 16384, tid); }
    __syncthreads();
    const int c = wid >> 2, qb = wid & 3, n = 2 * cp + c;
    const lds_cptr Vimg = lds + c * 65536, Simg = Vimg + 32768;
    const size_t chunk0 = (size_t)(b * SEQ + n * CH);
    const size_t qoff = (chunk0 + 32 * qb + r32) * 512 + h * 128;
    bf16x8 qf[8];
#pragma unroll
    for (int s = 0; s < 8; ++s) qf[s] = *(const bf16x8*)(QR + qoff + 16 * s + 8 * hi);
    f32x16 o[4];
#pragma unroll
    for (int t = 0; t < 4; ++t) { o[t] = f32x16{};
#pragma unroll
        for (int s = 0; s < 8; ++s) { const int Ra = 16 * s + 8 * hi; o[t] = __builtin_amdgcn_mfma_f32_32x32x16_bf16(tr_frag(Simg, Ra, Ra + 4, 32 * t, lane), qf[s], o[t], 0, 0, 0); } }
    { const float xi = exp2f(l2g * (float)(32 * qb + r32 + 1));
#pragma unroll
      for (int t = 0; t < 4; ++t)
#pragma unroll
          for (int r = 0; r < 16; ++r) o[t][r] *= xi; }
    for (int jb = 0; jb <= qb; ++jb) {
        f32x16 p = {};
        const bf16_t* kp = KR + (chunk0 + 32 * jb + r32) * 512 + h * 128 + 8 * hi;
#pragma unroll
        for (int s = 0; s < 8; ++s) p = __builtin_amdgcn_mfma_f32_32x32x16_bf16(*(const bf16x8*)(kp + 16 * s), qf[s], p, 0, 0, 0);
        const int dij = 32 * (qb - jb) + r32;
#pragma unroll
        for (int r = 0; r < 16; ++r) { const int d = dij - crow(r, hi); p[r] = d >= 0 ? p[r] * exp2f(l2g * (float)d) : 0.f; }
        u32x4 w0, w1; w0.x = cvt_pk(p[0], p[1]); w0.y = cvt_pk(p[2], p[3]); w0.z = cvt_pk(p[4], p[5]); w0.w = cvt_pk(p[6], p[7]);
        w1.x = cvt_pk(p[8], p[9]); w1.y = cvt_pk(p[10], p[11]); w1.z = cvt_pk(p[12], p[13]); w1.w = cvt_pk(p[14], p[15]);
        const bf16x8 pb0 = __builtin_bit_cast(bf16x8, w0), pb1 = __builtin_bit_cast(bf16x8, w1);
#pragma unroll
        for (int t = 0; t < 4; ++t) {
            const int R0 = 32 * jb + 4 * hi;
            o[t] = __builtin_amdgcn_mfma_f32_32x32x16_bf16(tr_frag(Vimg, R0, R0 + 8, 32 * t, lane), pb0, o[t], 0, 0, 0);
            o[t] = __builtin_amdgcn_mfma_f32_32x32x16_bf16(tr_frag(Vimg, R0 + 16, R0 + 24, 32 * t, lane), pb1, o[t], 0, 0, 0);
        }
    }
    float ss = 0.f;
#pragma unroll
    for (int t = 0; t < 4; ++t)
#pragma unroll
        for (int r = 0; r < 16; ++r) ss += o[t][r] * o[t][r];
    ss += __shfl_xor(ss, 32);
    const float rms = rsqrtf(ss * (1.f / 128.f) + 1e-6f);
#pragma unroll
    for (int t = 0; t < 4; ++t)
#pragma unroll
        for (int g = 0; g < 4; ++g) { const int dv0 = 32 * t + 8 * g + 4 * hi;
            const u32x2 gt = *(const u32x2*)(GR + qoff + dv0); const f32x4 rn = *(const f32x4*)(retnorm + h * 128 + dv0);
            u32x2 w; w.x = cvt_pk(lo16(gt.x) * o[t][4 * g] * rms * rn[0], hi16(gt.x) * o[t][4 * g + 1] * rms * rn[1]);
            w.y = cvt_pk(lo16(gt.y) * o[t][4 * g + 2] * rms * rn[2], hi16(gt.y) * o[t][4 * g + 3] * rms * rn[3]);
            *(u32x2*)(QR + qoff + dv0) = w; }
}
}
#define XB_TMO      128
#define XB_XCNT(j)  (256  + 64 * (j))
#define XB_XSUB(j)  (1280 + 64 * (j))
#define XB_XGEN(j)  (2304 + 64 * (j))
#define XB_TOP      3328
#define XB_TOPGEN   3392
#define XCD_BAR_WORDS 3456
#define XB_SPIN_CAP (1u << 18)

__device__ __forceinline__ unsigned xb_ld(unsigned* p)              { return __hip_atomic_load(p, __ATOMIC_RELAXED, __HIP_MEMORY_SCOPE_AGENT); }
__device__ __forceinline__ unsigned xb_add(unsigned* p, unsigned v) { return __hip_atomic_fetch_add(p, v, __ATOMIC_RELAXED, __HIP_MEMORY_SCOPE_AGENT); }
__device__ __forceinline__ unsigned xb_xcc_id() { return (unsigned)__builtin_amdgcn_s_getreg((3 << 11) | 20) & 0xFu; }
#define XB_SPIN(cond, bar) do { unsigned _sp = 0; while (cond) { __builtin_amdgcn_s_sleep(1); \
    if ((++_sp & 255u) == 0u) { if (xb_ld(&(bar)[XB_TMO])) break; if (_sp > XB_SPIN_CAP) { atomicAdd(&(bar)[XB_TMO], 1u); break; } } } } while (0)

struct XcdBarrier {
    unsigned* bar; unsigned x;
    volatile LAS unsigned* st;
};

__device__ __forceinline__ XcdBarrier xcd_barrier_post(unsigned* bar, volatile LAS unsigned* st) {
    XcdBarrier b; b.bar = bar; b.x = xb_xcc_id(); b.st = st;
    if (threadIdx.x == 0) (void)xb_add(&bar[XB_XCNT(b.x)], 1u);
    return b;
}
__device__ __forceinline__ void xcd_barrier_complete(unsigned* bar, unsigned x, unsigned& nloc, unsigned& nx) {
    const unsigned G = gridDim.x * gridDim.y * gridDim.z;
    unsigned sum, cnt, mine, sp = 0u;
    for (;;) {
        sum = 0u; cnt = 0u; mine = 0u;
#pragma unroll
        for (unsigned j = 0; j < 16; ++j) { const unsigned c = xb_ld(&bar[XB_XCNT(j)]); sum += c; cnt += (c > 0u) ? 1u : 0u; mine = (j == x) ? c : mine; }
        if (sum == G) break;
        __builtin_amdgcn_s_sleep(1);
        if ((++sp & 255u) == 0u) { if (xb_ld(&bar[XB_TMO])) break; if (sp > XB_SPIN_CAP) { atomicAdd(&bar[XB_TMO], 1u); break; } }
    }
    nloc = mine > 0u ? mine : 1u; nx = cnt > 0u ? cnt : 1u;
}

__device__ __forceinline__ void xcd_barrier(const XcdBarrier& b) {
    asm volatile("s_waitcnt vmcnt(0)" ::: "memory");
    __syncthreads();
    if (threadIdx.x == 0) {
        unsigned* bar = b.bar;
        __builtin_amdgcn_s_waitcnt(0);
        unsigned nloc = b.st[0], nx = b.st[1];
        if (nloc == 0u) { xcd_barrier_complete(bar, b.x, nloc, nx); b.st[0] = nloc; b.st[1] = nx; }
        const unsigned old = xb_add(&bar[XB_XSUB(b.x)], 1u);
        const unsigned gen = old / nloc;
        if (old + 1u == (gen + 1u) * nloc) {
            __builtin_amdgcn_fence(__ATOMIC_RELEASE, "agent");
            asm volatile("s_waitcnt vmcnt(0)" ::: "memory");
            const unsigned og = xb_add(&bar[XB_TOP], 1u);
            const unsigned tg = og / nx;
            if (og + 1u == (tg + 1u) * nx) xb_add(&bar[XB_TOPGEN], 1u);
            else XB_SPIN(xb_ld(&bar[XB_TOPGEN]) == tg, bar);
            __builtin_amdgcn_fence(__ATOMIC_ACQUIRE, "agent");
            xb_add(&bar[XB_XGEN(b.x)], 1u);
            asm volatile("s_waitcnt vmcnt(0)" ::: "memory");
        } else {
            XB_SPIN(xb_ld(&bar[XB_XGEN(b.x)]) == gen, bar);
            __builtin_amdgcn_fence(__ATOMIC_ACQUIRE, "agent");
            asm volatile("s_waitcnt vmcnt(0)" ::: "memory");
        }
    }
    __syncthreads();
}
constexpr int NWAVES = 8;
constexpr int RING_OFF = 0, RING_BYTES = 131072;
constexpr int LDSCTL_OFF = RING_BYTES, MISC_OFF = LDSCTL_OFF + 320;
constexpr int LDS_BYTES = 147456;
typedef GAS unsigned gu32;
typedef unsigned v4u __attribute__((ext_vector_type(4)));
typedef float f32x4 __attribute__((ext_vector_type(4)));
#define LDS_WAIT() asm volatile("s_waitcnt lgkmcnt(0)" ::: "memory")
#define VM_WAIT() asm volatile("s_waitcnt vmcnt(0)" ::: "memory")

struct Args { const float* in[15]; float* out; unsigned char* ws; int ph_lo, ph_hi, li, flags; };
enum { IN_X = 0, IN_NORM1, IN_W1IN, IN_W1OUT, IN_NORMMIX, IN_WIN, IN_BFORGET, IN_RETNORM, IN_WORET, IN_WOFOX, IN_WOUT, IN_NORM2, IN_W2IN, IN_W2OUT, IN_NORMFINAL };

struct Frame {
    LAS unsigned char* lds;
    volatile LAS unsigned* MISC;
    int wave, vcu, G;
};
__device__ __forceinline__ int tid_now() { int t = threadIdx.x; asm volatile("" : "+v"(t)); return t; }

__device__ __forceinline__ void p0_transpose_item(const float* W, int ldw, int srccol, int nvalid, const float* gain, int K, bf16_t* WT, int drow0, int k0, LAS float* scr, int lane) {
    const int n = lane & 31;
#pragma unroll 8
    for (int i = 0; i < 32; ++i) { const int kk = 2 * i + (lane >> 5);
        float v = 0.f; if (n < nvalid) { v = W[(size_t)(k0 + kk) * ldw + srccol + n]; if (gain) v *= gain[k0 + kk]; }
        scr[kk * 33 + n] = v; }
    LDS_WAIT(); asm volatile("" ::: "memory");
    const int c = lane & 7;
#pragma unroll
    for (int j = 0; j < 4; ++j) { const int nn = (lane >> 3) + 8 * j; const LAS float* s = scr + (8 * c) * 33 + nn;
        v4u o; o.x = pk2(s[0 * 33], s[1 * 33]); o.y = pk2(s[2 * 33], s[3 * 33]); o.z = pk2(s[4 * 33], s[5 * 33]); o.w = pk2(s[6 * 33], s[7 * 33]);
        *(GAS v4u*)(WT + (size_t)(drow0 + nn) * K + k0 + 8 * c) = o; }
    LDS_WAIT(); asm volatile("" ::: "memory");
}
__device__ __forceinline__ int src_col32(int kind, int rho0, int& nvalid) {
    nvalid = 32;
    if (kind == 0) return rho0;
    const int pn = rho0 >> 8, bj = (rho0 >> 7) & 1, j = rho0 & 127;
    if (kind == 1) return (bj ? DFF : 0) + 128 * pn + j;
    if (pn < 4) return (pn < 2 ? C_RQ : C_RK) + (2 * (pn & 1) + (j >> 6)) * 128 + 64 * bj + (j & 63);
    if (pn < 14) return rho0;
    if (pn < 22) return rho0 + 8;
    nvalid = (rho0 == 22 * 256) ? 8 : 0; return C_FF;
}
__device__ __forceinline__ void p0_convert(const float* W, int ldw, const float* gain, int K, bf16_t* WT, int N, int kind, int gw, int NGW, int& base, LAS float* scr, int lane) {
    const int nblk = N / 32, nitems = (K / 64) * nblk;
    int first = gw - (base % NGW); if (first < 0) first += NGW;
    for (int it = first; it < nitems; it += NGW) {
        const int kb = it / nblk, nb = it % nblk; int nvalid; const int sc = src_col32(kind, 32 * nb, nvalid);
        p0_transpose_item(W, ldw, sc, nvalid, gain, K, WT, 32 * nb, 64 * kb, scr, lane);
    }
    base += nitems;
}

constexpr int PH_PER_LAYER = 10, PH_FINAL = 1 + DEPTH * PH_PER_LAYER, N_PHASES = PH_FINAL + 1;
__global__ void __launch_bounds__(NWAVES * 64, 2) mega(Args args) {
    extern __shared__ __attribute__((aligned(16))) unsigned char lds[];
    Frame F;
    F.lds = (LAS unsigned char*)lds;
    F.MISC = (volatile LAS unsigned*)(F.lds + MISC_OFF);
    F.wave = __builtin_amdgcn_readfirstlane((int)threadIdx.x >> 6);
    F.G = gridDim.x; { const int bx = blockIdx.x; F.vcu = (F.G % 8 == 0) ? (bx % 8) * (F.G / 8) + bx / 8 : bx; }
    unsigned char* ws = args.ws;
    gu32* ctl = (gu32*)(ws + WS_CTL);
    for (int u = threadIdx.x; u < (LDS_BYTES - LDSCTL_OFF) / 4; u += NWAVES * 64) ((LAS unsigned*)(F.lds + LDSCTL_OFF))[u] = 0u;
    __syncthreads();
    XcdBarrier bar = xcd_barrier_post((unsigned*)(ctl + CW_BAR) + args.li * XCD_BAR_WORDS, F.MISC + 8);
    const int lo = args.ph_lo, hi = args.ph_hi;
#define IN(k) (lo <= (k) && (k) < hi)
#define SEAM(k) do { if (IN(k) && IN((k) + 1)) xcd_barrier(bar); } while (0)
    float* x = args.out;
    float* part = (float*)(ws + WS_PART);
    bf16_t* XB = (bf16_t*)(ws + WS_XB); bf16_t* HB = (bf16_t*)(ws + WS_H);
    const int gw = F.vcu * NWAVES + F.wave, NGW = F.G * NWAVES;

    if (IN(0)) {
        const int lane = tid_now() & 63;
        LAS float* scr = (LAS float*)(F.lds + RING_OFF + F.wave * 16384);
        int base = 0;
        for (int l = 0; l < DEPTH; ++l) {
            unsigned char* wl = ws + WS_W + (size_t)l * W_LAYER;
            p0_convert(args.in[IN_W1IN] + (size_t)l * D * 2 * DFF, 2 * DFF, args.in[IN_NORM1] + l * D, D, (bf16_t*)(wl + WO_1IN), 2 * DFF, 1, gw, NGW, base, scr, lane);
            p0_convert(args.in[IN_W1OUT] + (size_t)l * DFF * D, D, nullptr, DFF, (bf16_t*)(wl + WO_1OUT), D, 0, gw, NGW, base, scr, lane);
            p0_convert(args.in[IN_WIN] + (size_t)l * D * IN_COLS, IN_COLS, args.in[IN_NORMMIX] + l * D, D, (bf16_t*)(wl + WO_IN), NIN, 2, gw, NGW, base, scr, lane);
            p0_convert(args.in[IN_WORET] + (size_t)l * 512 * D, D, nullptr, 512, (bf16_t*)(wl + WO_OR), D, 0, gw, NGW, base, scr, lane);
            p0_convert(args.in[IN_WOFOX] + (size_t)l * 512 * D, D, nullptr, 512, (bf16_t*)(wl + WO_OF), D, 0, gw, NGW, base, scr, lane);
            p0_convert(args.in[IN_WOUT] + (size_t)l * D * D, D, nullptr, D, (bf16_t*)(wl + WO_OUT), D, 0, gw, NGW, base, scr, lane);
            p0_convert(args.in[IN_W2IN] + (size_t)l * D * 2 * DFF, 2 * DFF, args.in[IN_NORM2] + l * D, D, (bf16_t*)(wl + WO_2IN), 2 * DFF, 1, gw, NGW, base, scr, lane);
            p0_convert(args.in[IN_W2OUT] + (size_t)l * DFF * D, D, nullptr, DFF, (bf16_t*)(wl + WO_2OUT), D, 0, gw, NGW, base, scr, lane);
        }
        {
            float* cs = (float*)(ws + WS_COS); float* sn = (float*)(ws + WS_SIN);
            for (int idx = gw * 64 + lane; idx < SEQ * 64; idx += NGW * 64) { const int s = idx >> 6, i = idx & 63;
                const double inv = pow(10000.0, -(double)(2 * i) / 128.0), a = (double)s * inv; cs[idx] = (float)cos(a); sn[idx] = (float)sin(a); }
        }
        const float* xin = args.in[IN_X];
        for (int m = gw; m < M; m += NGW) {
            const GAS f32x4* xr = (const GAS f32x4*)(xin + (size_t)m * D) + lane; float s = 0.f;
#pragma unroll
            for (int j = 0; j < 4; ++j) { const f32x4 v = xr[64 * j]; s += (v[0] * v[0] + v[1] * v[1]) + (v[2] * v[2] + v[3] * v[3]);
                ((GAS f32x4*)(x + (size_t)m * D))[lane + 64 * j] = v;
                ((GAS unsigned long long*)(XB + (size_t)m * D))[lane + 64 * j] = (unsigned long long)pk2(v[0], v[1]) | ((unsigned long long)pk2(v[2], v[3]) << 32); }
            s = wave_sum(s);
            if (lane < 16) part[(size_t)m * 16 + lane] = lane == 0 ? s : 0.f;
        }
    }
    SEAM(0);

    for (int hl = 0; hl < 2 * DEPTH; ++hl) {
        const int l = hl >> 1, odd = hl & 1, pb = 1 + l * PH_PER_LAYER;
        unsigned char* wl = ws + WS_W + (size_t)l * W_LAYER;
        if (odd) {
        if (IN(pb + 2)) {
            pg8::Gemm g{XB, (const bf16_t*)(wl + WO_IN), M, NIN, D}; pg8::StaticOrder S; S.init(M, NIN, F.G, (int)blockIdx.x);
            pg8::EpiInproj E{part, (const float*)(ws + WS_COS), (const float*)(ws + WS_SIN), args.in[IN_BFORGET] + l * FH, ws, (float*)(ws + WS_LFT)};
            pg8::gemm_phase<pg8::EpiInproj, pg8::StaticOrder, true, true>(F.lds + RING_OFF, g, S, E);
        }
        SEAM(pb + 2);
        if (IN(pb + 3)) {
            if (args.flags & 1) { const fox::AttnTensors AT{(const fox::bf16*)(ws + WS_FQ), (const fox::bf16*)(ws + WS_FK), (const fox::bf16*)(ws + WS_FV), (fox::bf16*)(ws + WS_FQ)};
                const fox::StaticOrder S((int)F.G, (int)blockIdx.x); fox::attn_phase<fox::StaticOrder>((char*)lds + RING_OFF, AT, (const float*)(ws + WS_LFT), S); }
            if (args.flags & 2) for (int id = F.vcu; id < 512; id += F.G) ret::retkv_unit(id >> 5, id & 31, (const bf16_t*)(ws + WS_KR), (const bf16_t*)(ws + WS_VR), (float*)(ws + WS_KVS), (LAS char*)(F.lds + RING_OFF));
        }
        SEAM(pb + 3);
        if (IN(pb + 4)) { if (args.flags & 2) ret::ret_scan((float*)(ws + WS_KVS), F.vcu * (NWAVES * 64) + tid_now(), F.G * NWAVES * 64); }
        SEAM(pb + 4);
        if (IN(pb + 5)) {
            if (args.flags & 2) for (int id = F.vcu; id < 256; id += F.G) ret::retout_unit(id >> 4, id & 15, (bf16_t*)(ws + WS_QR), (const bf16_t*)(ws + WS_KR), (const bf16_t*)(ws + WS_VR), (const bf16_t*)(ws + WS_GR),
                                                                                            (const float*)(ws + WS_KVS), args.in[IN_RETNORM] + l * 512, (LAS char*)(F.lds + RING_OFF));
        }
        SEAM(pb + 5);
        if (IN(pb + 6)) {
            { pg8::Gemm g{(const bf16_t*)(ws + WS_QR), (const bf16_t*)(wl + WO_OR), M, D, 512}; pg8::StaticOrder S; S.init(M, D, F.G, (int)blockIdx.x);
              pg8::EpiGateT E{(const bf16_t*)(ws + WS_GATER), (bf16_t*)(ws + WS_T)}; pg8::gemm_phase<pg8::EpiGateT, pg8::StaticOrder, true, true>(F.lds + RING_OFF, g, S, E); }
            VM_WAIT(); __syncthreads(); __builtin_amdgcn_fence(__ATOMIC_ACQUIRE, "agent"); VM_WAIT(); __syncthreads();
            { pg8::Gemm g{(const bf16_t*)(ws + WS_FQ), (const bf16_t*)(wl + WO_OF), M, D, 512}; pg8::StaticOrder S; S.init(M, D, F.G, (int)blockIdx.x);
              pg8::EpiMergeF E{(const bf16_t*)(ws + WS_GATEF), (const bf16_t*)(ws + WS_T), (bf16_t*)(ws + WS_MERGED)}; pg8::gemm_phase<pg8::EpiMergeF, pg8::StaticOrder, true, true>(F.lds + RING_OFF, g, S, E); }
        }
        SEAM(pb + 6);
        if (IN(pb + 7)) {
            pg8::Gemm g{(const bf16_t*)(ws + WS_MERGED), (const bf16_t*)(wl + WO_OUT), M, D, D}; pg8::StaticOrder S; S.init(M, D, F.G, (int)blockIdx.x);
            pg8::EpiResid E{x, XB, part, 1.f}; pg8::gemm_phase<pg8::EpiResid, pg8::StaticOrder, true, true>(F.lds + RING_OFF, g, S, E);
        }
        SEAM(pb + 7);
        }
        const int kin = pb + (odd ? 8 : 0), kout = kin + 1;
        if (IN(kin)) { pg8::Gemm g{XB, (const bf16_t*)(wl + (odd ? WO_2IN : WO_1IN)), M, 2 * DFF, D}; pg8::StaticOrder S; S.init(M, 2 * DFF, F.G, (int)blockIdx.x);
            pg8::EpiSwiglu E{HB, part}; pg8::gemm_phase<pg8::EpiSwiglu, pg8::StaticOrder, true, true>(F.lds + RING_OFF, g, S, E); }
        SEAM(kin);
        if (IN(kout)) { pg8::Gemm g{HB, (const bf16_t*)(wl + (odd ? WO_2OUT : WO_1OUT)), M, D, DFF}; pg8::StaticOrder S; S.init(M, D, F.G, (int)blockIdx.x);
            pg8::EpiResid E{x, XB, part, 0.5f}; pg8::gemm_phase<pg8::EpiResid, pg8::StaticOrder, true, true>(F.lds + RING_OFF, g, S, E); }
        SEAM(kout);
    }
    if (IN(PH_FINAL)) {
        const float* g = args.in[IN_NORMFINAL]; const int lane = tid_now() & 63;
        for (int m = gw; m < M; m += NGW) {
            float ps = lane < 16 ? part[(size_t)m * 16 + lane] : 0.f; ps = wave_sum(ps);
            const float rstd = rsqrtf(ps * (1.f / D) + EPS);
            GAS f32x4* xr = (GAS f32x4*)(x + (size_t)m * D) + lane;
#pragma unroll
            for (int j = 0; j < 4; ++j) { const f32x4 v = xr[64 * j], gg = ((const GAS f32x4*)g)[lane + 64 * j]; xr[64 * j] = v * rstd * gg; }
        }
    }
#undef IN
#undef SEAM
}
__global__ __launch_bounds__(128) void k_slow_retention(bf16_t* QR, const bf16_t* KR, const bf16_t* VR, const bf16_t* GR, const float* ret_norm) {
    const int bh = blockIdx.x, b = bh / RH, h = bh % RH, j = threadIdx.x;
    const float gamma = 1.f - exp2f(-5.f - (float)h);
    float S[128];
#pragma unroll
    for (int i = 0; i < 128; ++i) S[i] = 0.f;
    __shared__ float qs[128], ks[128], red[2];
    const float rn = ret_norm[h * 128 + j];
    for (int t = 0; t < SEQ; ++t) {
        const size_t o = (size_t)(b * SEQ + t) * 512 + h * 128 + j;
        qs[j] = bf2f(QR[o]); ks[j] = bf2f(KR[o]);
        const float v = bf2f(VR[o]), g = bf2f(GR[o]);
        __syncthreads();
        float out = 0.f;
#pragma unroll
        for (int i = 0; i < 128; ++i) { S[i] = gamma * S[i] + ks[i] * v; out += qs[i] * S[i]; }
        const float ss = wave_sum(out * out);
        if ((j & 63) == 0) red[j >> 6] = ss;
        __syncthreads();
        const float tot = red[0] + red[1];
        QR[o] = f2bf(g * (out * rsqrtf(tot * (1.f / 128.f) + EPS)) * rn);
    }
}

__global__ void k_cumsum(const float* lft, float* cum) {
    if (threadIdx.x != 0) return;
    const float* p = lft + (size_t)blockIdx.x * SEQ; float* c = cum + (size_t)blockIdx.x * SEQ;
    double a = 0.0;
    for (int s = 0; s < SEQ; ++s) { a += (double)p[s]; c[s] = (float)(a * 1.4426950408889634); }
}

__global__ __launch_bounds__(64) void k_slow_fox(bf16_t* FQ, const bf16_t* FK, const bf16_t* FV, const float* cum) {
    const int bh = blockIdx.y, b = bh / FH, h = bh % FH, qi = blockIdx.x * 64 + threadIdx.x;
    __shared__ float Ks[64][64], Vs[64][64], cs[64];
    float q[64], o[64];
    const size_t qo = (size_t)(b * SEQ + qi) * 512 + h * 64;
#pragma unroll
    for (int d = 0; d < 64; ++d) { q[d] = bf2f(FQ[qo + d]); o[d] = 0.f; }
    const float cq = cum[(size_t)bh * SEQ + qi];
    float mx = -1e30f, l = 0.f;
    const int qmax = blockIdx.x * 64 + 63;
    for (int t0 = 0; t0 <= qmax; t0 += 64) {
        __syncthreads();
        for (int e = threadIdx.x; e < 64 * 64; e += 64) { const int r = e >> 6, c = e & 63; const size_t ko = (size_t)(b * SEQ + t0 + r) * 512 + h * 64 + c; Ks[r][c] = bf2f(FK[ko]); Vs[r][c] = bf2f(FV[ko]); }
        cs[threadIdx.x] = cum[(size_t)bh * SEQ + t0 + threadIdx.x];
        __syncthreads();
        for (int kk = 0; kk < 64; ++kk) {
            if (t0 + kk > qi) break;
            float s = 0.f;
#pragma unroll
            for (int d = 0; d < 64; ++d) s += q[d] * Ks[kk][d];
            s += cq - cs[kk];
            const float mn = fmaxf(mx, s), sc = exp2f(mx - mn), p = exp2f(s - mn);
            l = l * sc + p; mx = mn;
#pragma unroll
            for (int d = 0; d < 64; ++d) o[d] = o[d] * sc + p * Vs[kk][d];
        }
    }
    const float il = 1.f / l;
#pragma unroll
    for (int d = 0; d < 64; ++d) FQ[qo + d] = f2bf(o[d] * il);
}

#ifndef SLOW_MIXER
#define SLOW_MIXER 0
#endif
extern "C" void kernel_launch(void* const* d_in, const int* in_sizes, int n_in, void* d_out, int out_size, void* d_ws, size_t ws_size, hipStream_t stream) {
    static int grid = 0;
    if (grid == 0) {
        if (n_in != 15 || out_size != M * D || ws_size < WS_END) { fprintf(stderr, "kernel_launch: unexpected shapes (n_in %d out %d ws %zu, need %zu)\n", n_in, out_size, ws_size, (size_t)WS_END); grid = -1; return; }
        int dev = 0, cus = 0, per_cu = 0;
        if (hipGetDevice(&dev) != hipSuccess || hipDeviceGetAttribute(&cus, hipDeviceAttributeMultiprocessorCount, dev) != hipSuccess) { grid = -1; return; }
        if (hipFuncSetAttribute((const void*)mega, hipFuncAttributeMaxDynamicSharedMemorySize, LDS_BYTES) != hipSuccess) { fprintf(stderr, "kernel_launch: hipFuncSetAttribute failed\n"); grid = -1; return; }
        if (hipOccupancyMaxActiveBlocksPerMultiprocessor(&per_cu, (const void*)mega, NWAVES * 64, LDS_BYTES) != hipSuccess || per_cu < 1) { fprintf(stderr, "kernel_launch: occupancy query says %d\n", per_cu); }
        (void)hipGetLastError();
        grid = cus;
        if (grid != 256) { fprintf(stderr, "kernel_launch: built for a 256-CU device (the attention / retention unit deals assume 256 workgroups), found %d\n", cus); grid = -1; return; }
    }
    if (grid < 0) return;
    unsigned char* ws = (unsigned char*)d_ws;
    (void)hipMemsetAsync(ws + WS_CTL, 0, CTL_BYTES, stream);
    Args a{};
    for (int i = 0; i < 15; ++i) a.in[i] = (const float*)d_in[i];
    a.out = (float*)d_out; a.ws = ws;
    int li = 0;
#define LAUNCH(lo_, hi_) do { a.ph_lo = (lo_); a.ph_hi = (hi_); a.li = li++; hipLaunchKernelGGL(mega, dim3(grid), dim3(NWAVES * 64), LDS_BYTES, stream, a); } while (0)
#if SLOW_MIXER
    int lo = 0;
    a.flags = 3 & ~SLOW_MIXER;
    for (int l = 0; l < DEPTH; ++l) {
        const int pb = 1 + l * PH_PER_LAYER;
        LAUNCH(lo, pb + 3);
        LAUNCH(pb + 3, pb + 6);
        if (SLOW_MIXER & 2) hipLaunchKernelGGL(k_slow_retention, dim3(BATCH * RH), dim3(128), 0, stream, (bf16_t*)(ws + WS_QR), (const bf16_t*)(ws + WS_KR), (const bf16_t*)(ws + WS_VR), (const bf16_t*)(ws + WS_GR), (const float*)d_in[IN_RETNORM] + l * 512);
        if (SLOW_MIXER & 1) { hipLaunchKernelGGL(k_cumsum, dim3(BATCH * FH), dim3(64), 0, stream, (const float*)(ws + WS_LFT), (float*)(ws + WS_CUM));
            hipLaunchKernelGGL(k_slow_fox, dim3(SEQ / 64, BATCH * FH), dim3(64), 0, stream, (bf16_t*)(ws + WS_FQ), (const bf16_t*)(ws + WS_FK), (const bf16_t*)(ws + WS_FV), (const float*)(ws + WS_CUM)); }
        lo = pb + 6;
    }
    LAUNCH(lo, N_PHASES);
#else
    a.flags = 3;
    LAUNCH(0, N_PHASES);
#endif
}
```

```cpp
#include <hip/hip_runtime.h>
#include <cstdio>
#include <cstdint>

typedef unsigned short bf16_t;
#ifndef PROBE_DUP
#define PROBE_DUP 0
#endif
#ifndef PROBE_SPIN
#define PROBE_SPIN 0
#endif
#define PROBE_TAGSEL 0

constexpr int D = 1024, BATCH = 4, SEQ = 4096, DEPTH = 4, M = BATCH * SEQ;
constexpr int RH = 4, RDK = 128, FH = 8, FD = 64, DFF = 2816, IN_COLS = 5640;
constexpr int NIN = 5888;
constexpr float EPS = 1e-6f;
constexpr int C_RQ = 0, C_RK = 512, C_RV = 1024, C_RG = 1536, C_FQ = 2048, C_FK = 2560, C_FV = 3072, C_FF = 3584, C_GR = 3592, C_GF = 4616;
constexpr float FOX_C2 = 0.125f * 1.4426950408889634f;
constexpr float RET_KSCALE = 0.08838834764831845f;

constexpr size_t MiB = 1u << 20;
constexpr size_t WS_CTL = 0, CTL_BYTES = 1 * MiB;
constexpr size_t WS_PART = 1 * MiB;
constexpr size_t WS_COS = 2 * MiB, WS_SIN = 3 * MiB;
constexpr size_t WS_LFT = 4 * MiB;
constexpr size_t WS_CUM = 4 * MiB + 512 * 1024;
constexpr size_t WS_XB = 8 * MiB;
constexpr size_t WS_QR = 40 * MiB, WS_KR = 56 * MiB, WS_VR = 72 * MiB, WS_GR = 88 * MiB, WS_FQ = 104 * MiB, WS_FK = 120 * MiB, WS_FV = 136 * MiB;
constexpr size_t WS_GATER = 152 * MiB, WS_GATEF = 184 * MiB;
constexpr size_t WS_H = 40 * MiB;
constexpr size_t WS_MERGED = 56 * MiB;
constexpr size_t WS_T = 120 * MiB;
constexpr size_t WS_W = 216 * MiB;
constexpr size_t WO_1IN = 0, WO_1OUT = 11 * MiB, WO_IN = WO_1OUT + 5632 * 1024, WO_OR = WO_IN + (size_t)NIN * 2048, WO_OF = WO_OR + MiB, WO_OUT = WO_OF + MiB,
                 WO_2IN = WO_OUT + 2 * MiB, WO_2OUT = WO_2IN + 11 * MiB, W_LAYER = WO_2OUT + 5632 * 1024;
constexpr size_t WS_END = WS_W + DEPTH * W_LAYER;
static_assert(W_LAYER == 48 * MiB + 512 * 1024, "weights per layer");

constexpr int CW_GRP = 65536;
constexpr int CW_BAR = 4096;

#define GAS __attribute__((address_space(1)))
#define LAS __attribute__((address_space(3)))
__device__ __forceinline__ float bf2f(bf16_t v) { return __uint_as_float((unsigned)v << 16); }
__device__ __forceinline__ bf16_t f2bf(float f) { unsigned u = __float_as_uint(f); return (bf16_t)((u + 0x7fffu + ((u >> 16) & 1u)) >> 16); }
__device__ __forceinline__ unsigned pk2(float lo, float hi) { return (unsigned)f2bf(lo) | ((unsigned)f2bf(hi) << 16); }
__device__ __forceinline__ float silu_f(float v) { return v / (1.f + __expf(-v)); }
__device__ __forceinline__ float sigmoid_f(float v) { return 1.f / (1.f + __expf(-v)); }
__device__ __forceinline__ float logsigmoid_f(float z) { return z >= 0.f ? -log1pf(expf(-z)) : z - log1pf(expf(z)); }
__device__ __forceinline__ float wave_sum(float v) {
#pragma unroll
    for (int o = 1; o < 64; o <<= 1) v += __shfl_xor(v, o);
    return v;
}
namespace pg8 {
#define PG8_LAS __attribute__((address_space(3)))
typedef unsigned short bf16_t;
typedef short bf16x8 __attribute__((ext_vector_type(8)));
typedef float f32x4 __attribute__((ext_vector_type(4)));
typedef unsigned u32x4 __attribute__((ext_vector_type(4)));
constexpr int BM = 256, BK = 64, HALF = 128, HTB = HALF * BK * 2  , STAGE_BYTES = 8 * HTB, NXCD = 8, WGM = 8;

__host__ __device__ __forceinline__ int lds_byte(int r, int c) { const int st = (r >> 4) * 2 + (c >> 5), rr = r & 15, cc = c & 31, ob = rr * 64 + cc * 2; return st * 1024 + (ob ^ (((ob >> 9) & 1) << 5)); }
__host__ __device__ __forceinline__ void stage_rc(int b, int& R, int& C) { const int st = b / 1024, sb = b % 1024, swz = sb ^ (((sb >> 9) & 1) << 5); R = (st >> 1) * 16 + swz / 64; C = (st & 1) * 32 + (swz % 64) / 2; }
__host__ __device__ __forceinline__ int perm32(int rho) { const int n = rho >> 4, i = rho & 15; return 8 * (i >> 2) + 4 * n + (i & 3); }

struct Unit { int pm, pn; };
struct Gemm { const bf16_t* A; const bf16_t* Bt; int M, N, K; };

struct StaticOrder {
    int nM, nN, nwg, G, c;
    __device__ void init(int M, int N, int G_, int c_) {
        asm volatile("" : "+s"(c_), "+s"(G_));
        nM = M / BM; nN = N / BM; nwg = nM * nN; G = G_; c = c_; }
    __host__ __device__ bool next(int i, Unit& u) const {
        const long L = (long)i * G + c; if (L >= nwg) return false;
        int wgid = (int)L; { const int q = nwg / NXCD, r = nwg % NXCD, xcd = wgid % NXCD, off = wgid / NXCD; wgid = (xcd < r ? xcd * (q + 1) : r * (q + 1) + (xcd - r) * q) + off; }
        const int nig = WGM * nN, gid = wgid / nig, fm = gid * WGM, gsz = (nM - fm) < WGM ? (nM - fm) : WGM;
        u.pm = fm + ((wgid % nig) % gsz); u.pn = (wgid % nig) / gsz; return true;
    }
    __device__ __forceinline__ void a_ready(const Unit&) const {}
    __device__ __forceinline__ void done(const Unit&) const {}
};
template <class Epi, class Sched, bool ALIGN_EPI = false, bool SP2 = false>
__device__ __forceinline__ void gemm_phase(PG8_LAS unsigned char* lds, const Gemm g, const Sched& S, const Epi& E) {
    int tid_ = threadIdx.x; asm volatile("" : "+v"(tid_));
    const int tid = tid_, wid = __builtin_amdgcn_readfirstlane(tid >> 6), lane = tid & 63, wr = wid >> 2, wc = wid & 3, fr = lane & 15, fq = lane >> 4;
    const int K = g.K, nt = K / BK;
    unsigned voffA[2], voffB[2];
#pragma unroll
    for (int i = 0; i < 2; ++i) { int R, C; stage_rc(tid * 16 + i * 8192, R, C); const int Rb = Epi::PERM ? ((R & ~31) + perm32(R & 31)) : R;
        voffA[i] = (unsigned)(R * K + C) * 2u; voffB[i] = (unsigned)(Rb * K + C) * 2u; }
    const size_t kstep = (size_t)(BK * 2);
    const size_t hstep = (size_t)HALF * K * 2;
    const size_t tstep = 2 * hstep;
    const unsigned ldsw = (unsigned)wid * 1024u;
    const int aoff = lds_byte(wr * 64 + fr, fq * 8), boff = lds_byte(wc * 32 + fr, fq * 8);
#define PG8_SA(b, h) (((b) * 2 + (h)) * HTB)
#define PG8_SB(b, h) ((4 + (b) * 2 + (h)) * HTB)
#define PG8_STAGE(bufoff, gbase, voff) do { _Pragma("unroll") for (int _i = 0; _i < 2; ++_i) \
        __builtin_amdgcn_global_load_lds((const unsigned*)((const char*)(gbase) + (voff)[_i]), (PG8_LAS unsigned*)(lds + (bufoff) + ldsw + _i * 8192), 16, 0, 0); } while (0)
#define PG8_LDA(dst, b, h) do { _Pragma("unroll") for (int m = 0; m < 4; ++m) _Pragma("unroll") for (int k = 0; k < 2; ++k) dst[m][k] = *(const PG8_LAS bf16x8*)(lds + PG8_SA(b, h) + aoff + m * 2048 + k * 1024); } while (0)
#define PG8_LDB(dst, b, h) do { _Pragma("unroll") for (int n = 0; n < 2; ++n) _Pragma("unroll") for (int k = 0; k < 2; ++k) dst[n][k] = *(const PG8_LAS bf16x8*)(lds + PG8_SB(b, h) + boff + n * 2048 + k * 1024); } while (0)
#define PG8_MMA(ai, bj, At, Bt) do { __builtin_amdgcn_s_setprio(1); _Pragma("unroll") for (int m = 0; m < 4; ++m) _Pragma("unroll") for (int n = 0; n < 2; ++n) _Pragma("unroll") for (int k = 0; k < 2; ++k) \
        acc[ai][bj][m][n] = __builtin_amdgcn_mfma_f32_16x16x32_bf16(Bt[n][k], At[m][k], acc[ai][bj][m][n], 0, 0, 0); __builtin_amdgcn_s_setprio(0); } while (0)
#define PG8_WAIT_V(n) asm volatile("s_waitcnt vmcnt(" #n ")" ::: "memory")
#define PG8_WAIT_L(n) asm volatile("s_waitcnt lgkmcnt(" #n ")" ::: "memory")
#define PG8_BAR __builtin_amdgcn_s_barrier()
#define PG8_SCHED __builtin_amdgcn_sched_barrier(0)
    Unit cur, nxt; int ui = 0;
    if (!S.next(0, cur)) return;
    f32x4 acc[2][2][4][2];
    if constexpr (Epi::INIT_ACC) E.init(acc, cur, wr, wc, fr, fq);
    else {
#pragma unroll
    for (int a = 0; a < 2; ++a)
#pragma unroll
        for (int b = 0; b < 2; ++b)
#pragma unroll
            for (int m = 0; m < 4; ++m)
#pragma unroll
                for (int n = 0; n < 2; ++n) acc[a][b][m][n] = (f32x4){0.f, 0.f, 0.f, 0.f};
    }
    bf16x8 At[4][2], B0[2][2], B1[2][2];
    const char* cA = (const char*)g.A + (size_t)cur.pm * tstep; const char* cB = (const char*)g.Bt + (size_t)cur.pn * tstep;
    S.a_ready(cur);
    if constexpr (SP2) {
        PG8_STAGE(PG8_SB(0, 0), cB, voffB); PG8_STAGE(PG8_SB(0, 1), cB + hstep, voffB); PG8_STAGE(PG8_SA(0, 0), cA, voffA); PG8_STAGE(PG8_SA(0, 1), cA + hstep, voffA);
        PG8_STAGE(PG8_SB(1, 0), cB + kstep, voffB); PG8_STAGE(PG8_SA(1, 0), cA + kstep, voffA); PG8_STAGE(PG8_SB(1, 1), cB + hstep + kstep, voffB);
        if (wr == 1) PG8_BAR;
        PG8_WAIT_V(8); PG8_BAR;
        PG8_WAIT_V(6); PG8_BAR;
    } else {
        PG8_STAGE(PG8_SB(0, 0), cB, voffB); PG8_STAGE(PG8_SA(0, 0), cA, voffA); PG8_STAGE(PG8_SB(0, 1), cB + hstep, voffB); PG8_STAGE(PG8_SA(0, 1), cA + hstep, voffA);
        if (wr == 1) PG8_BAR;
        PG8_WAIT_V(4); PG8_BAR;
        PG8_STAGE(PG8_SB(1, 0), cB + kstep, voffB); PG8_STAGE(PG8_SA(1, 0), cA + kstep, voffA); PG8_STAGE(PG8_SB(1, 1), cB + hstep + kstep, voffB);
        PG8_WAIT_V(6); PG8_BAR;
    }
    for (;;) {
        const bool has_next = S.next(ui + 1, nxt);
        const char* nA = has_next ? (const char*)g.A + (size_t)nxt.pm * tstep : cA; const char* nB = has_next ? (const char*)g.Bt + (size_t)nxt.pn * tstep : cB;
#if defined(PROBE_SPIN) && (PROBE_SPIN == 4)
        unsigned pk0_ = 0; if constexpr (Epi::PROBE_TAG) pk0_ = (unsigned)__builtin_amdgcn_s_memrealtime();
#endif
        for (int t = 0; t < nt; t += 2) {
            const bool last = (t == nt - 2);
            const char* a1 = cA + (size_t)(t + 1) * kstep;
            const char* a2 = last ? nA : cA + (size_t)(t + 2) * kstep; const char* b2 = last ? nB : cB + (size_t)(t + 2) * kstep;
            const char* a3 = a2 + kstep; const char* b3 = b2 + kstep;
            if (last && has_next) S.a_ready(nxt);
            if constexpr (Epi::MIDHOOK) { if (t == nt / 2) E.mid(acc, cur, wr, wc, fr, fq); }
            if constexpr (SP2) {
#define PG8_WAIT_V8S do { if constexpr (Epi::NSTORE == 8) { int f_ = __builtin_amdgcn_readfirstlane((int)((t == 0) & (ui > 0))); asm volatile("" : "+s"(f_));   \
                if (f_) PG8_WAIT_V(16); else PG8_WAIT_V(8); } else PG8_WAIT_V(8); } while (0)
            PG8_LDB(B0, 0, 0); PG8_LDB(B1, 0, 1); PG8_SCHED; PG8_LDA(At, 0, 0); PG8_STAGE(PG8_SA(1, 1), a1 + hstep, voffA);
            PG8_WAIT_V8S; PG8_WAIT_L(0); PG8_BAR; PG8_MMA(0, 0, At, B0); PG8_MMA(0, 1, At, B1); PG8_BAR; PG8_SCHED;
            PG8_LDA(At, 0, 1); PG8_STAGE(PG8_SB(0, 0), b2, voffB); PG8_STAGE(PG8_SB(0, 1), b2 + hstep, voffB); PG8_STAGE(PG8_SA(0, 0), a2, voffA);
            PG8_WAIT_V8S; PG8_WAIT_L(0); PG8_BAR; PG8_MMA(1, 0, At, B0); PG8_MMA(1, 1, At, B1); PG8_BAR; PG8_SCHED;
#undef PG8_WAIT_V8S
            PG8_LDB(B0, 1, 0); PG8_LDB(B1, 1, 1); PG8_SCHED; PG8_LDA(At, 1, 0); PG8_STAGE(PG8_SA(0, 1), a2 + hstep, voffA);
            PG8_WAIT_V(8); PG8_WAIT_L(0); PG8_BAR; PG8_MMA(0, 0, At, B0); PG8_MMA(0, 1, At, B1); PG8_BAR; PG8_SCHED;
            PG8_LDA(At, 1, 1); PG8_STAGE(PG8_SB(1, 0), b3, voffB); PG8_STAGE(PG8_SB(1, 1), b3 + hstep, voffB); PG8_STAGE(PG8_SA(1, 0), a3, voffA);
            PG8_WAIT_V(8); PG8_WAIT_L(0); PG8_BAR; PG8_MMA(1, 0, At, B0); PG8_MMA(1, 1, At, B1); PG8_BAR; PG8_SCHED;
            } else {
            PG8_LDB(B0, 0, 0); PG8_SCHED; PG8_LDA(At, 0, 0); PG8_STAGE(PG8_SA(1, 1), a1 + hstep, voffA);
            PG8_WAIT_L(8); PG8_BAR; PG8_WAIT_L(0); PG8_MMA(0, 0, At, B0); PG8_BAR; PG8_SCHED;
            PG8_LDB(B1, 0, 1); PG8_STAGE(PG8_SB(0, 0), b2, voffB);
            PG8_BAR; PG8_WAIT_L(0); PG8_MMA(0, 1, At, B1); PG8_BAR;
            PG8_LDA(At, 0, 1); PG8_STAGE(PG8_SA(0, 0), a2, voffA);
            PG8_BAR; PG8_WAIT_L(0); PG8_MMA(1, 0, At, B0); PG8_BAR; PG8_SCHED;
            PG8_STAGE(PG8_SB(0, 1), b2 + hstep, voffB);
            PG8_WAIT_V(6); PG8_BAR; PG8_MMA(1, 1, At, B1); PG8_BAR;
            PG8_LDB(B0, 1, 0); PG8_SCHED; PG8_LDA(At, 1, 0); PG8_STAGE(PG8_SA(0, 1), a2 + hstep, voffA);
            PG8_WAIT_L(8); PG8_BAR; PG8_WAIT_L(0); PG8_MMA(0, 0, At, B0); PG8_BAR; PG8_SCHED;
            PG8_LDB(B1, 1, 1); PG8_STAGE(PG8_SB(1, 0), b3, voffB);
            PG8_BAR; PG8_WAIT_L(0); PG8_MMA(0, 1, At, B1); PG8_BAR;
            PG8_LDA(At, 1, 1); PG8_STAGE(PG8_SA(1, 0), a3, voffA);
            PG8_BAR; PG8_WAIT_L(0); PG8_MMA(1, 0, At, B0); PG8_BAR; PG8_SCHED;
            PG8_STAGE(PG8_SB(1, 1), b3 + hstep, voffB);
            PG8_WAIT_V(6); PG8_BAR; PG8_MMA(1, 1, At, B1); PG8_BAR;
            }
        }
#if defined(PROBE_SPIN) && (PROBE_SPIN == 4)
        if constexpr (Epi::PROBE_TAG) { if (threadIdx.x == 0) { volatile PG8_LAS unsigned* mi_ = (volatile PG8_LAS unsigned*)(lds + 131072 + 320); mi_[16] = mi_[16] + ((unsigned)__builtin_amdgcn_s_memrealtime() - pk0_); } }
#endif
        if constexpr (ALIGN_EPI) { if (wr == 0) PG8_BAR; }
#if defined(PROBE_SPIN) && (PROBE_SPIN == 3)
        unsigned pe0_ = 0; if constexpr (Epi::PROBE_TAG) pe0_ = (unsigned)__builtin_amdgcn_s_memrealtime();
#endif
        if constexpr (!Epi::AFTER_DRAIN) { E(acc, cur, wr, wc, fr, fq);
#if defined(PROBE_SPIN) && (PROBE_SPIN == 3)
            if constexpr (Epi::PROBE_TAG) { asm volatile("s_waitcnt vmcnt(0)" ::: "memory"); if (threadIdx.x == 0) { volatile PG8_LAS unsigned* mi_ = (volatile PG8_LAS unsigned*)(lds + 131072 + 320); mi_[16] = mi_[16] + ((unsigned)__builtin_amdgcn_s_memrealtime() - pe0_); } }
#endif
#if defined(PROBE_DUP) && (PROBE_DUP & 512)
            if constexpr (Epi::IDEMPOTENT) { asm volatile("" ::: "memory"); E(acc, cur, wr, wc, fr, fq); }
#endif
            S.done(cur); }
        if (!has_next) break;
        if constexpr (Epi::INIT_ACC) E.init(acc, nxt, wr, wc, fr, fq);
        else {
#pragma unroll
        for (int a = 0; a < 2; ++a)
#pragma unroll
            for (int b = 0; b < 2; ++b)
#pragma unroll
                for (int m = 0; m < 4; ++m)
#pragma unroll
                    for (int n = 0; n < 2; ++n) acc[a][b][m][n] = (f32x4){0.f, 0.f, 0.f, 0.f};
        }
        cur = nxt; cA = nA; cB = nB; ++ui;
        if constexpr (ALIGN_EPI) { if (wr == 1) PG8_BAR; }
    }
    PG8_WAIT_V(0);
    if constexpr (!ALIGN_EPI) { if (wr == 0) PG8_BAR; }
    PG8_BAR;
    if constexpr (Epi::AFTER_DRAIN) { E.fused(acc, cur, wr, wc, fr, fq, lds, wid, lane); S.done(cur); }
#undef PG8_SA
#undef PG8_SB
#undef PG8_STAGE
#undef PG8_LDA
#undef PG8_LDB
#undef PG8_MMA
#undef PG8_WAIT_V
#undef PG8_WAIT_L
#undef PG8_BAR
#undef PG8_SCHED
}
}
namespace pg8 {
__device__ __forceinline__ unsigned cvt_pk_bf16(float lo, float hi) { unsigned r; asm volatile("v_cvt_pk_bf16_f32 %0, %1, %2" : "=v"(r) : "v"(lo), "v"(hi)); return r; }
__device__ __forceinline__ u32x4 pack8(const f32x4 a, const f32x4 b) { u32x4 w; w.x = cvt_pk_bf16(a[0], a[1]); w.y = cvt_pk_bf16(a[2], a[3]); w.z = cvt_pk_bf16(b[0], b[1]); w.w = cvt_pk_bf16(b[2], b[3]); return w; }
__device__ __forceinline__ f32x4 unpack_lo(const u32x4 w) { return (f32x4){__uint_as_float(w.x << 16), __uint_as_float(w.x & 0xffff0000u), __uint_as_float(w.y << 16), __uint_as_float(w.y & 0xffff0000u)}; }
__device__ __forceinline__ f32x4 unpack_hi(const u32x4 w) { return (f32x4){__uint_as_float(w.z << 16), __uint_as_float(w.z & 0xffff0000u), __uint_as_float(w.w << 16), __uint_as_float(w.w & 0xffff0000u)}; }
__device__ __forceinline__ float fast_sigmoid(float v) { return __builtin_amdgcn_rcpf(1.f + __builtin_amdgcn_exp2f(-1.4426950408889634f * v)); }
__device__ __forceinline__ float fast_logsigmoid(float z) { return fminf(z, 0.f) - 0.6931471805599453f * __builtin_amdgcn_logf(1.f + __builtin_amdgcn_exp2f(-1.4426950408889634f * fabsf(z))); }
__device__ __forceinline__ f32x4 sigmoid4(const f32x4 v) { return (f32x4){fast_sigmoid(v[0]), fast_sigmoid(v[1]), fast_sigmoid(v[2]), fast_sigmoid(v[3])}; }
__device__ __forceinline__ f32x4 silu4(const f32x4 v) { return v * sigmoid4(v); }
__device__ __forceinline__ void store_wt(void* p, const u32x4 v) { asm volatile("global_store_dwordx4 %0, %1, off sc1\n\ts_nop 1" :: "v"(p), "v"(v) : "memory"); }
__device__ __forceinline__ float rstd_row(const float* part, int row, int fq) {
    const f32x4 p = *(const f32x4*)(part + (size_t)row * 16 + 4 * fq);
    float s = (p[0] + p[1]) + (p[2] + p[3]);
    s += __shfl_xor(s, 16); s += __shfl_xor(s, 32);
    return rsqrtf(s * (1.f / 1024.f) + 1e-6f);
}

__device__ __forceinline__ void rstd_rows8(const float* part, int row0, int fq, float (&r)[2][4]) {
    f32x4 p[2][4];
#pragma unroll
    for (int ai = 0; ai < 2; ++ai)
#pragma unroll
        for (int m = 0; m < 4; ++m) p[ai][m] = *(const f32x4*)(part + (size_t)(row0 + ai * HALF + m * 16) * 16 + 4 * fq);
#pragma unroll
    for (int ai = 0; ai < 2; ++ai)
#pragma unroll
        for (int m = 0; m < 4; ++m) { float s = (p[ai][m][0] + p[ai][m][1]) + (p[ai][m][2] + p[ai][m][3]); s += __shfl_xor(s, 16); s += __shfl_xor(s, 32); r[ai][m] = rsqrtf(s * (1.f / 1024.f) + 1e-6f); }
}

struct RstdTab { const float* part; const PG8_LAS float* tab; int pm0; };
__device__ __forceinline__ void rstd_fill(const float* part, int pm, PG8_LAS float* tab, int tid) {
    if (__builtin_amdgcn_readfirstlane(tid >> 6) < 4) {     const f32x4* p = (const f32x4*)(part + (size_t)(pm * BM + tid) * 16); const f32x4 a = p[0], b = p[1], c = p[2], d = p[3];
        const float s = ((a[0] + a[1]) + (a[2] + a[3])) + ((b[0] + b[1]) + (b[2] + b[3])) + ((c[0] + c[1]) + (c[2] + c[3])) + ((d[0] + d[1]) + (d[2] + d[3]));
        tab[tid] = rsqrtf(s * (1.f / 1024.f) + 1e-6f); }
    __syncthreads();
}
__device__ __forceinline__ void rstd_get8(const RstdTab& T, const Unit& u, int wr, int fr, int fq, float (&r)[2][4]) {
    if (u.pm == T.pm0) {
#pragma unroll
        for (int ai = 0; ai < 2; ++ai)
#pragma unroll
            for (int m = 0; m < 4; ++m) r[ai][m] = T.tab[wr * 64 + fr + ai * HALF + m * 16];
    } else rstd_rows8(T.part, u.pm * BM + wr * 64 + fr, fq, r);
}

struct EpiSwiglu {
    static constexpr bool INIT_ACC = false, PERM = true, AFTER_DRAIN = false, MIDHOOK = false, IDEMPOTENT = true, PROBE_TAG = (PROBE_TAGSEL == 0);
    bf16_t* H; RstdTab rt;
    static constexpr int NSTORE = 8;
    __device__ __forceinline__ void operator()(const f32x4 (&acc)[2][2][4][2], const Unit& u, int wr, int wc, int fr, int fq) const {
        const int row0 = u.pm * BM + wr * 64 + fr, hcol = u.pn * 128 + wc * 32 + 8 * fq;
        float rr[2][4]; rstd_get8(rt, u, wr, fr, fq, rr);
#pragma unroll
        for (int ai = 0; ai < 2; ++ai)
#pragma unroll
            for (int m = 0; m < 4; ++m) {
                const int row = row0 + ai * HALF + m * 16; const float r = rr[ai][m], nr = -1.4426950408889634f * r, r2 = r * r;
                f32x4 h[2];
#pragma unroll
                for (int n = 0; n < 2; ++n) { const f32x4 a = acc[ai][0][m][n], t = a * nr;
                    const f32x4 d = (f32x4){__builtin_amdgcn_exp2f(t[0]), __builtin_amdgcn_exp2f(t[1]), __builtin_amdgcn_exp2f(t[2]), __builtin_amdgcn_exp2f(t[3])} + 1.f;
                    const f32x4 sg = (f32x4){__builtin_amdgcn_rcpf(d[0]), __builtin_amdgcn_rcpf(d[1]), __builtin_amdgcn_rcpf(d[2]), __builtin_amdgcn_rcpf(d[3])};
                    h[n] = ((a * acc[ai][1][m][n]) * sg) * r2; }
                store_wt(H + (size_t)row * 2816 + hcol, pack8(h[0], h[1]));
            }
    }
};
struct EpiResid {
    static constexpr bool INIT_ACC = true, PROBE_TAG = (PROBE_TAGSEL == 2), PERM = true, AFTER_DRAIN = false, MIDHOOK = false, IDEMPOTENT = false;
    bf16_t* xb; float* part; float alpha, inv_alpha;
    static constexpr int NSTORE = 0;
    __device__ __forceinline__ void init(f32x4 (&acc)[2][2][4][2], const Unit& u, int wr, int wc, int fr, int fq) const {
        const int row0 = u.pm * BM + wr * 64 + fr, col0 = u.pn * BM + wc * 32 + 8 * fq;
#pragma unroll
        for (int ai = 0; ai < 2; ++ai)
#pragma unroll
            for (int m = 0; m < 4; ++m)
#pragma unroll
                for (int bj = 0; bj < 2; ++bj) { const u32x4 w = *(const u32x4*)(xb + (size_t)(row0 + ai * HALF + m * 16) * 1024 + col0 + bj * HALF);
                    acc[ai][bj][m][0] = unpack_lo(w) * inv_alpha; acc[ai][bj][m][1] = unpack_hi(w) * inv_alpha; }
    }
    __device__ __forceinline__ void operator()(const f32x4 (&acc)[2][2][4][2], const Unit& u, int wr, int wc, int fr, int fq) const {
        const int row0 = u.pm * BM + wr * 64 + fr, col0 = u.pn * BM + wc * 32 + 8 * fq;
#pragma unroll
        for (int ai = 0; ai < 2; ++ai)
#pragma unroll
            for (int m = 0; m < 4; ++m) {
                const int row = row0 + ai * HALF + m * 16; float ss = 0.f;
#pragma unroll
                for (int bj = 0; bj < 2; ++bj) {
                    const u32x4 w = pack8(acc[ai][bj][m][0] * alpha, acc[ai][bj][m][1] * alpha);
                    *(u32x4*)(xb + (size_t)row * 1024 + col0 + bj * HALF) = w;
                    const f32x4 v0 = unpack_lo(w), v1 = unpack_hi(w);
                    ss += (v0[0] * v0[0] + v0[1] * v0[1]) + (v0[2] * v0[2] + v0[3] * v0[3]) + (v1[0] * v1[0] + v1[1] * v1[1]) + (v1[2] * v1[2] + v1[3] * v1[3]);
                }
                ss += __shfl_xor(ss, 16); ss += __shfl_xor(ss, 32);
                if (fq == 0) part[(size_t)row * 16 + u.pn * 4 + wc] = ss;
            }
    }
};
struct EpiInproj {
    static constexpr bool INIT_ACC = false, PROBE_TAG = (PROBE_TAGSEL == 1), PERM = true, AFTER_DRAIN = false, MIDHOOK = false, IDEMPOTENT = true;
    RstdTab rt; const float* cs; const float* sn; const float* bforget; unsigned char* ws; float* lft;
    static constexpr int NSTORE = 0;
    __device__ __forceinline__ void operator()(const f32x4 (&acc)[2][2][4][2], const Unit& u, int wr, int wc, int fr, int fq) const {
        const int row0 = u.pm * BM + wr * 64 + fr, pn = u.pn;
        float rr[2][4]; rstd_get8(rt, u, wr, fr, fq, rr);
        if (pn < 4) {
            bf16_t* dst = (bf16_t*)(ws + (pn < 2 ? WS_QR : WS_KR)); const float scale = pn < 2 ? 1.f : RET_KSCALE;
            const int head = 2 * (pn & 1) + (wc >> 1), i0 = 32 * (wc & 1) + 8 * fq;
            f32x4 cv[3][2], sv[3][2];
#define ROPE_LD(j, slot) do { const int s = (row0 + ((j) >> 2) * HALF + ((j) & 3) * 16) & (SEQ - 1); \
                cv[slot][0] = *(const f32x4*)(cs + s * 64 + i0); cv[slot][1] = *(const f32x4*)(cs + s * 64 + i0 + 4); sv[slot][0] = *(const f32x4*)(sn + s * 64 + i0); sv[slot][1] = *(const f32x4*)(sn + s * 64 + i0 + 4); } while (0)
            ROPE_LD(0, 0); ROPE_LD(1, 1);
#pragma unroll
            for (int j = 0; j < 8; ++j) { const int ai = j >> 2, m = j & 3, cb = j % 3;
                if (j < 6) ROPE_LD(j + 2, (j + 2) % 3);
                const int row = row0 + ai * HALF + m * 16; const float r = rr[ai][m] * scale;
                const f32x4 a0 = acc[ai][0][m][0] * r, a1 = acc[ai][0][m][1] * r, b0 = acc[ai][1][m][0] * r, b1 = acc[ai][1][m][1] * r;
                bf16_t* o = dst + (size_t)row * 512 + head * 128 + i0;
                *(u32x4*)o = pack8(a0 * cv[cb][0] - b0 * sv[cb][0], a1 * cv[cb][1] - b1 * sv[cb][1]);
                *(u32x4*)(o + 64) = pack8(a0 * sv[cb][0] + b0 * cv[cb][0], a1 * sv[cb][1] + b1 * cv[cb][1]);
            }
#undef ROPE_LD
        } else if (pn < 14) {
            const int grp = (pn - 4) >> 1;
            const size_t off = grp == 0 ? WS_VR : grp == 1 ? WS_GR : grp == 2 ? WS_FQ : grp == 3 ? WS_FK : WS_FV;
            const float scale = grp == 2 ? FOX_C2 : 1.f;
            bf16_t* dst = (bf16_t*)(ws + off) + 256 * (pn & 1) + wc * 32 + 8 * fq;
#pragma unroll
            for (int ai = 0; ai < 2; ++ai)
#pragma unroll
                for (int m = 0; m < 4; ++m) {
                    const int row = row0 + ai * HALF + m * 16; const float r = rr[ai][m] * scale;
#pragma unroll
                    for (int bj = 0; bj < 2; ++bj) {
                        f32x4 v0 = acc[ai][bj][m][0] * r, v1 = acc[ai][bj][m][1] * r;
                        if (grp == 1) { v0 = silu4(v0); v1 = silu4(v1); }
                        *(u32x4*)(dst + (size_t)row * 512 + bj * HALF) = pack8(v0, v1);
                    }
                }
        } else if (pn < 22) {
            const int colg = 128 * (pn - 14) + wc * 32 + 8 * fq;
#pragma unroll
            for (int ai = 0; ai < 2; ++ai)
#pragma unroll
                for (int m = 0; m < 4; ++m) {
                    const int row = row0 + ai * HALF + m * 16; const float nr = -1.4426950408889634f * rr[ai][m];
                    f32x4 rt[2], sf[2];
#pragma unroll
                    for (int n = 0; n < 2; ++n) { const f32x4 tr = acc[ai][0][m][n] * nr, tf = acc[ai][1][m][n] * nr;
                        const f32x4 dr = (f32x4){__builtin_amdgcn_exp2f(tr[0]), __builtin_amdgcn_exp2f(tr[1]), __builtin_amdgcn_exp2f(tr[2]), __builtin_amdgcn_exp2f(tr[3])} + 1.f;
                        const f32x4 df = (f32x4){__builtin_amdgcn_exp2f(tf[0]), __builtin_amdgcn_exp2f(tf[1]), __builtin_amdgcn_exp2f(tf[2]), __builtin_amdgcn_exp2f(tf[3])} + 1.f;
                        sf[n] = (f32x4){__builtin_amdgcn_rcpf(df[0]), __builtin_amdgcn_rcpf(df[1]), __builtin_amdgcn_rcpf(df[2]), __builtin_amdgcn_rcpf(df[3])};
                        rt[n] = df * (f32x4){__builtin_amdgcn_rcpf(dr[0]), __builtin_amdgcn_rcpf(dr[1]), __builtin_amdgcn_rcpf(dr[2]), __builtin_amdgcn_rcpf(dr[3])}; }
                    *(u32x4*)((bf16_t*)(ws + WS_GATER) + (size_t)row * 1024 + colg) = pack8(rt[0], rt[1]);
                    *(u32x4*)((bf16_t*)(ws + WS_GATEF) + (size_t)row * 1024 + colg) = pack8(sf[0], sf[1]);
                }
        } else if (wc == 0) {
            float bfv[8];
#pragma unroll
            for (int hd = 0; hd < 8; ++hd) bfv[hd] = __int_as_float(__builtin_amdgcn_readfirstlane(__float_as_int(bforget[hd])));
            if (fq == 0) {
#pragma unroll
                for (int ai = 0; ai < 2; ++ai)
#pragma unroll
                    for (int m = 0; m < 4; ++m) {
                        const int row = row0 + ai * HALF + m * 16; const float r = rr[ai][m];
                        const int b = row >> 12, s = row & (SEQ - 1);
                        float* dst = lft + (size_t)(b * FH) * SEQ + s;
#pragma unroll
                        for (int n = 0; n < 2; ++n)
#pragma unroll
                            for (int e = 0; e < 4; ++e) { const int hd = 4 * n + e; dst[(size_t)hd * SEQ] = fast_logsigmoid(acc[ai][0][m][n][e] * r + bfv[hd]); }
                    }
            }
        }
    }
};
struct EpiGated {
    static constexpr bool INIT_ACC = false, PROBE_TAG = (PROBE_TAGSEL == 3), PERM = true, AFTER_DRAIN = false, MIDHOOK = true, IDEMPOTENT = true;
    const bf16_t* ratio; const bf16_t* sigf; bf16_t* out;
    static constexpr int NSTORE = 0;
    __device__ __forceinline__ void mid(f32x4 (&acc)[2][2][4][2], const Unit& u, int wr, int wc, int fr, int fq) const {
        asm volatile("" : "+v"(fr), "+v"(fq));
        const int row0 = u.pm * BM + wr * 64 + fr, col0 = u.pn * BM + wc * 32 + 8 * fq;
        u32x4 g[2][4][2];
#pragma unroll
        for (int ai = 0; ai < 2; ++ai)
#pragma unroll
            for (int m = 0; m < 4; ++m)
#pragma unroll
                for (int bj = 0; bj < 2; ++bj) g[ai][m][bj] = *(const u32x4*)(ratio + (size_t)(row0 + ai * HALF + m * 16) * 1024 + col0 + bj * HALF);
#pragma unroll
        for (int ai = 0; ai < 2; ++ai)
#pragma unroll
            for (int m = 0; m < 4; ++m)
#pragma unroll
                for (int bj = 0; bj < 2; ++bj) { acc[ai][bj][m][0] *= unpack_lo(g[ai][m][bj]); acc[ai][bj][m][1] *= unpack_hi(g[ai][m][bj]); }
    }
    __device__ __forceinline__ void operator()(const f32x4 (&acc)[2][2][4][2], const Unit& u, int wr, int wc, int fr, int fq) const {
        const int row0 = u.pm * BM + wr * 64 + fr, col0 = u.pn * BM + wc * 32 + 8 * fq;
        u32x4 g[2][4][2];
#pragma unroll
        for (int ai = 0; ai < 2; ++ai)
#pragma unroll
            for (int m = 0; m < 4; ++m)
#pragma unroll
                for (int bj = 0; bj < 2; ++bj) g[ai][m][bj] = *(const u32x4*)(sigf + (size_t)(row0 + ai * HALF + m * 16) * 1024 + col0 + bj * HALF);
#pragma unroll
        for (int ai = 0; ai < 2; ++ai)
#pragma unroll
            for (int m = 0; m < 4; ++m)
#pragma unroll
                for (int bj = 0; bj < 2; ++bj)
                    store_wt(out + (size_t)(row0 + ai * HALF + m * 16) * 1024 + col0 + bj * HALF, pack8(unpack_lo(g[ai][m][bj]) * acc[ai][bj][m][0], unpack_hi(g[ai][m][bj]) * acc[ai][bj][m][1]));
    }
};
}
#include <hip/hip_bf16.h>
namespace fox {
using bf16=__hip_bfloat16;
using bf16x8=__attribute__((ext_vector_type(8)))short;
using s16x4=__attribute__((ext_vector_type(4)))short;
using f32x16=__attribute__((ext_vector_type(16)))float;
using u32x4=__attribute__((ext_vector_type(4)))unsigned;
constexpr int BATCH=4,NHEAD=8,SEQ=4096,D=64,DM=NHEAD*D;
constexpr int NW=8,QBLK=32,QB=QBLK*NW,KVBLK=64,NQB=SEQ/QB;
constexpr int ATTN_PITCH=DM, ATTN_UNIT_ROWS=QB, OPITCH=1024;
__device__ __forceinline__ int crow(int r,int hi){return (r&3)+8*(r>>2)+4*hi;}
#define SBAR() __builtin_amdgcn_sched_barrier(0)
__device__ __forceinline__ void cmask(f32x16&p0,f32x16&p1,int jb,int qrel,int hi){
  const float NEG=-INFINITY; int kb=64*jb+4*hi;
  #pragma unroll
  for(int r=0;r<16;++r){int kv=kb+(r&3)+8*(r>>2); if(kv>qrel)p0[r]=NEG; if(kv+32>qrel)p1[r]=NEG;}
}

constexpr int NSLOT=3, SLOTB=8192;
constexpr int LDS_K=0, LDS_V=NSLOT*SLOTB, LDS_WS=2*NSLOT*SLOTB, LDS_OST=LDS_WS+NW*64*4, LDS_CUM=LDS_OST+NW*4096, LDS_BYTES=LDS_CUM+(SEQ+8)*8;
constexpr float C2=0.125f*1.4426950408889634f;
__device__ __forceinline__ void glds16(const void*gsrc,unsigned lds_dst){unsigned keep;
  asm volatile("s_mov_b32 %0, m0\n\ts_mov_b32 m0, %2\n\ts_nop 0\n\tglobal_load_lds_dwordx4 %1, off\n\ts_mov_b32 m0, %0":"=&s"(keep):"v"(gsrc),"s"(lds_dst):"memory");}
__device__ __forceinline__ float max3f(float a,float b,float c){float r;asm("v_max3_f32 %0, %1, %2, %3":"=v"(r):"v"(a),"v"(b),"v"(c));return r;}
__device__ __forceinline__ float max2f(float a,float b){float r;asm("v_max_f32_e32 %0, %1, %2":"=v"(r):"v"(a),"v"(b));return r;}
__device__ __forceinline__ float fadd_s(float a,float b){float r;asm("v_add_f32_e32 %0, %1, %2":"=v"(r):"v"(a),"v"(b));return r;}
__device__ __forceinline__ float fsub_s(float a,float b){float r;asm("v_sub_f32_e32 %0, %1, %2":"=v"(r):"v"(a),"v"(b));return r;}
typedef float f32x2_t __attribute__((ext_vector_type(2))); typedef __bf16 bf16x2_t __attribute__((ext_vector_type(2)));
__device__ __forceinline__ unsigned cvtpk_s(float lo,float hi){f32x2_t v={lo,hi};bf16x2_t b=__builtin_convertvector(v,bf16x2_t);return __builtin_bit_cast(unsigned,b);}
#define WAIT_BAR(N) asm volatile("s_waitcnt vmcnt(" #N ") lgkmcnt(0)\n\ts_barrier":::"memory")

__device__ __forceinline__ void qkt(f32x16&p0,f32x16&p1,const char*Kslot,const bf16x8*qr,const f32x16&i0,const f32x16&i1,int r32,int hi){
  const char*kb=Kslot+hi*1024+r32*16;
  #pragma unroll
  for(int d0=0;d0<4;++d0){
    const bf16x8 b0=*reinterpret_cast<const bf16x8*>(kb+d0*2048);
    const bf16x8 b1=*reinterpret_cast<const bf16x8*>(kb+d0*2048+512);
    if(d0==0){p0=__builtin_amdgcn_mfma_f32_32x32x16_bf16(b0,qr[0],i0,0,0,0);p1=__builtin_amdgcn_mfma_f32_32x32x16_bf16(b1,qr[0],i1,0,0,0);}
    else{p0=__builtin_amdgcn_mfma_f32_32x32x16_bf16(b0,qr[d0],p0,0,0,0);p1=__builtin_amdgcn_mfma_f32_32x32x16_bf16(b1,qr[d0],p1,0,0,0);}}
}
typedef __attribute__((address_space(3))) const char* lds_cptr;
typedef short v4i16_t __attribute__((ext_vector_type(4)));
__device__ __forceinline__ void kload8(bf16x8*kf,lds_cptr kp){
  kf[0]=*(const __attribute__((address_space(3))) bf16x8*)(kp);      kf[1]=*(const __attribute__((address_space(3))) bf16x8*)(kp+512);
  kf[2]=*(const __attribute__((address_space(3))) bf16x8*)(kp+2048); kf[3]=*(const __attribute__((address_space(3))) bf16x8*)(kp+2560);
  kf[4]=*(const __attribute__((address_space(3))) bf16x8*)(kp+4096); kf[5]=*(const __attribute__((address_space(3))) bf16x8*)(kp+4608);
  kf[6]=*(const __attribute__((address_space(3))) bf16x8*)(kp+6144); kf[7]=*(const __attribute__((address_space(3))) bf16x8*)(kp+6656);
}
__device__ __forceinline__ void kload2(bf16x8*kf,lds_cptr kp,int j){ kf[2*j]=*(const __attribute__((address_space(3))) bf16x8*)(kp+j*2048); kf[2*j+1]=*(const __attribute__((address_space(3))) bf16x8*)(kp+j*2048+512); }
__device__ __forceinline__ s16x4 vtr(lds_cptr p){ return __builtin_bit_cast(s16x4,__builtin_amdgcn_ds_read_tr16_b64_v4i16((__attribute__((address_space(3))) v4i16_t*)p)); }
__device__ __forceinline__ float rowmax(const f32x16&p0,const f32x16&p1){
  float a=max3f(p0[0],p0[1],p1[0]),b=max3f(p0[2],p0[3],p1[1]);a=max3f(a,p1[2],p1[3]);
  #pragma unroll
  for(int r=4;r<16;r+=4){a=max3f(a,p0[r],p0[r+1]);b=max3f(b,p0[r+2],p0[r+3]);a=max3f(a,p1[r],p1[r+1]);b=max3f(b,p1[r+2],p1[r+3]);}
  const float m=max2f(a,b);
  auto rr=__builtin_amdgcn_permlane32_swap(__float_as_uint(m),__float_as_uint(m),false,false);
  return max2f(__uint_as_float(rr[0]),__uint_as_float(rr[1]));
}
__device__ __forceinline__ void pv(f32x16*o,int vb,bf16x8 pa0,bf16x8 pa1,bf16x8 pa2,bf16x8 pa3){
  #pragma unroll
  for(int d0=0;d0<2;++d0){s16x4 lo[4],hi[4];
    #pragma unroll
    for(int ks=0;ks<4;++ks){
      asm volatile("ds_read_b64_tr_b16 %0,%1 offset:%c2":"=&v"(lo[ks]):"v"(vb),"i"(d0*4096+ks*1024):"memory");
      asm volatile("ds_read_b64_tr_b16 %0,%1 offset:%c2":"=&v"(hi[ks]):"v"(vb),"i"(d0*4096+ks*1024+512):"memory");}
    asm volatile("s_waitcnt lgkmcnt(0)":::"memory");SBAR();
    #define PK(k) (bf16x8){lo[k][0],lo[k][1],lo[k][2],lo[k][3],hi[k][0],hi[k][1],hi[k][2],hi[k][3]}
    o[d0]=__builtin_amdgcn_mfma_f32_32x32x16_bf16(pa0,PK(0),o[d0],0,0,0);
    o[d0]=__builtin_amdgcn_mfma_f32_32x32x16_bf16(pa1,PK(1),o[d0],0,0,0);
    o[d0]=__builtin_amdgcn_mfma_f32_32x32x16_bf16(pa2,PK(2),o[d0],0,0,0);
    o[d0]=__builtin_amdgcn_mfma_f32_32x32x16_bf16(pa3,PK(3),o[d0],0,0,0);
    #undef PK
  }
}

#ifndef ATTN_STORE16
#define ATTN_STORE16(p,v) (*(u32x4*)(p)=(v))
#endif
template<int THRL> __device__ __forceinline__ void attn_unit(int b,int h,int qb,const bf16*Q,const bf16*__restrict__ K,const bf16*__restrict__ V,bf16*O,char*shm){
  int tid_=threadIdx.x; asm volatile("":"+v"(tid_)); const int tid=tid_,lane=tid&63,r32=lane&31,hi=lane>>5; const int wid=__builtin_amdgcn_readfirstlane(tid>>6);
  const long rowbase=(long)b*SEQ; const int q0=qb*QB;
  const bf16*Qw=Q+(rowbase+q0+wid*QBLK)*DM+h*D;
  const bf16*Kh=K+rowbase*DM+h*D,*Vh=V+rowbase*DM+h*D;
  const lds_cptr shm3=(lds_cptr)shm;
  const unsigned lds0=(unsigned)(uintptr_t)shm;
  float*wsf=(float*)(shm+LDS_WS)+wid*64;
  const bf16*ksrc=Kh+(long)lane*DM+wid*8;
  const bf16*vsrc=Vh+(long)(16*(wid&3)+(lane>>2))*DM+(wid>>2)*32+(lane&3)*8;
  const unsigned kdst=lds0+LDS_K+wid*1024, vdst=lds0+LDS_V+wid*1024;
  #define TILE(t) (((t)<NT-4)?(NT-5-(t)):(t))
  #define DMA_K(t,slot) glds16(ksrc+(long)TILE(t)*KVBLK*DM,(unsigned)__builtin_amdgcn_readfirstlane(kdst+(slot)))
  #define DMA_V(t,slot) glds16(vsrc+(long)TILE(t)*KVBLK*DM,(unsigned)__builtin_amdgcn_readfirstlane(vdst+(slot)))
  const int vb0=(int)(lds0+LDS_V)+((lane>>4)&1)*32+(lane&3)*8+(4*hi+((lane&15)>>2))*64;
  const char*Kbase=shm+LDS_K; bf16x8 kf[8];
  const lds_cptr kp0=shm3+LDS_K+hi*1024+r32*16; const lds_cptr vp0=shm3+LDS_V+((lane>>4)&1)*32+(lane&3)*8+(4*hi+((lane&15)>>2))*64;
  const int NT=(q0+QB)/KVBLK;
  DMA_K(0,0);DMA_V(0,0);DMA_K(1,SLOTB);
  bf16x8 qr[4];
  #pragma unroll
  for(int d0=0;d0<4;++d0)qr[d0]=*reinterpret_cast<const bf16x8*>(&Qw[(long)r32*DM+d0*16+hi*8]);
  typedef unsigned u32x2_t __attribute__((ext_vector_type(2)));
  typedef __attribute__((address_space(3))) const u32x2_t* lds_ct;
  const lds_ct ctab=(lds_ct)(shm3+LDS_CUM);
  float cq; { const u32x2_t e=ctab[q0+wid*QBLK+r32]; cq=-((__uint_as_float(e[0]<<16)+__uint_as_float(e[0]&0xffff0000u))+__uint_as_float(e[1]<<16)); }
  float mhat=0.f,l_reg=0.f;f32x16 o[2];o[0]=f32x16{};o[1]=f32x16{};
  u32x4 qx;
  const unsigned one2=hi?0u:0x3F803F80u;
  #define SETQX(S_) do{ const float s_=(S_); const unsigned w_=cvtpk_s(s_,0.f); const float r1_=s_-__uint_as_float(w_<<16); const unsigned w2_=cvtpk_s(r1_,0.f); const float r2_=r1_-__uint_as_float(w2_<<16); \
      qx[0]=one2; qx[1]=hi?0u:(0x3F80u|(w_<<16)); qx[2]=hi?0u:((w2_&0xffffu)|(cvtpk_s(r2_,0.f)<<16)); qx[3]=0u; asm volatile("":"+v"(qx)); }while(0)
  SETQX(cq);
  const int ctoff=hi?SEQ:r32;
  #define KXF(T_,H_) ({ const u32x2_t e_=ctab[hi?SEQ:(64*(T_)+32*(H_)+r32)]; u32x4 k_; k_[0]=e_[0]; k_[1]=e_[1]; k_[2]=one2; k_[3]=0u; __builtin_bit_cast(bf16x8,k_); })
  u32x2_t kxa,kxb;
  #define KXLOAD(T_) do{ kxa=ctab[hi?SEQ:(64*(T_)+r32)]; kxb=ctab[hi?SEQ:(64*(T_)+32+r32)]; }while(0)
  #define BIASP(C0,C1) do{ const f32x16 z_=f32x16{}; const bf16x8 qxb_=__builtin_bit_cast(bf16x8,qx); u32x4 ka_,kb_; ka_[0]=kxa[0]; ka_[1]=kxa[1]; ka_[2]=one2; ka_[3]=0u; kb_[0]=kxb[0]; kb_[1]=kxb[1]; kb_[2]=one2; kb_[3]=0u; \
      C0=__builtin_amdgcn_mfma_f32_32x32x16_bf16(__builtin_bit_cast(bf16x8,ka_),qxb_,z_,0,0,0); C1=__builtin_amdgcn_mfma_f32_32x32x16_bf16(__builtin_bit_cast(bf16x8,kb_),qxb_,z_,0,0,0); }while(0)
  #define BIAS0(C0,C1,T_) do{ const f32x16 z_=f32x16{}; const bf16x8 qxb_=__builtin_bit_cast(bf16x8,qx); \
      C0=__builtin_amdgcn_mfma_f32_32x32x16_bf16(KXF(T_,0),qxb_,z_,0,0,0); C1=__builtin_amdgcn_mfma_f32_32x32x16_bf16(KXF(T_,1),qxb_,z_,0,0,0); }while(0)
  const int qrel=wid*QBLK+r32;
  #define CMASK(P0,P1,t) do{int jb_=(t)-(NT-4); if(jb_>=0)cmask(P0,P1,jb_,qrel,hi);}while(0)
  bool resc=false;
  #define START(P0,P1) do{ const float rm=rowmax(P0,P1); resc=false; \
    { const float dl=rm; mhat=fadd_s(mhat,dl); \
      _Pragma("unroll") for(int r=0;r<16;++r){P0[r]=fsub_s(P0[r],dl);P1[r]=fsub_s(P1[r],dl);} \
      SETQX(cq-mhat); } \
    _Pragma("unroll") for(int r=0;r<16;++r)P0[r]=__builtin_amdgcn_exp2f(P0[r]); }while(0)
  #define RESC() do{ if(resc){ asm volatile("s_waitcnt lgkmcnt(0)":::"memory"); \
      _Pragma("unroll") for(int d_=0;d_<2;++d_) _Pragma("unroll") for(int r=0;r<16;++r)o[d_][r]*=wsf[crow(r,hi)]; } }while(0)
  f32x16 pA0,pA1,pB0,pB1;
  int sl_prev=0,sl_cur=0,sl_next=SLOTB;
  #define ROT() do{sl_prev=sl_cur;sl_cur=sl_next;sl_next=(sl_next==(NSLOT-1)*SLOTB)?0:sl_next+SLOTB;}while(0)
  DMA_K(2,2*SLOTB);
  WAIT_BAR(3);
  { f32x16 i0_,i1_; BIAS0(i0_,i1_,TILE(0)); qkt(pA0,pA1,Kbase,qr,i0_,i1_,r32,hi); } asm volatile("s_nop 15\n\ts_nop 7":"+v"(pA0),"+v"(pA1));CMASK(pA0,pA1,0);
  START(pA0,pA1);
  _Pragma("unroll") for(int r=0;r<16;++r)pA1[r]=__builtin_amdgcn_exp2f(pA1[r]);
  WAIT_BAR(0);
  DMA_K(3,0);DMA_V(1,SLOTB);
  ROT();
  kload8(kf,kp0+sl_cur);
  WAIT_BAR(2);
  s16x4 vlo[8],vhi[8]; u32x4 pw0,pw1,pw2,pw3;
  #define PKW(P,B) cvtpk_s(P[B],P[B+1])
  #define PAF(k) __builtin_bit_cast(bf16x8,pw##k)
  #define VFR(i) (bf16x8){vlo[i][0],vlo[i][1],vlo[i][2],vlo[i][3],vhi[i][0],vhi[i][1],vhi[i][2],vhi[i][3]}
  #define PIN(x) asm volatile("":"+v"(x))
  #define MX3(a,b,c) __builtin_fmaxf(__builtin_fmaxf((a),(b)),(c))
  #define GAPA(MF,A0,A1,A2,A3,W0,W1,PW) do{ MF; sacc+=A0; sacc+=A1; sacc+=A2; sacc+=A3; PIN(sacc); W0; W1; PIN(PW); SBAR(); }while(0)
  #define EX(v) __builtin_amdgcn_exp2f(v)
  #define GAPB(MF,X,B) do{ MF; X[B]=EX(X[B]); X[B+1]=EX(X[B+1]); X[B+2]=EX(X[B+2]); X[B+3]=EX(X[B+3]); PIN(X); SBAR(); }while(0)
  #define VRD(i) do{ vlo[i]=vtr(vp_+(((i)>>2)*4096+((i)&3)*1024)); vhi[i]=vtr(vp_+(((i)>>2)*4096+((i)&3)*1024+512)); }while(0)
  #define KRD(G,j) do{ if(G){ kload2(kf,kp0+sl_next,j); SBAR(); } }while(0)
  #define STEP(C0,C1,P0,P1,t,GK,GV,GL) do{ SBAR(); \
    const lds_cptr vp_=vp0+sl_prev; \
    BIASP(C0,C1); KXLOAD(TILE((t)+1)); SBAR(); \
    VRD(0); SBAR(); float sacc=(P0[0]+P0[1]); \
    GAPA(C0=__builtin_amdgcn_mfma_f32_32x32x16_bf16(kf[0],qr[0],C0,0,0,0), P0[2],P0[3],P0[4],P0[5],     pw0[0]=PKW(P0,0), pw0[1]=PKW(P0,2), pw0); \
    VRD(4); SBAR(); GAPA(C1=__builtin_amdgcn_mfma_f32_32x32x16_bf16(kf[1],qr[0],C1,0,0,0), P0[6],P0[7],P0[8],P0[9],     pw0[2]=PKW(P0,4), pw0[3]=PKW(P0,6), pw0); \
    VRD(1); SBAR(); GAPA(C0=__builtin_amdgcn_mfma_f32_32x32x16_bf16(kf[2],qr[1],C0,0,0,0),   P0[10],P0[11],P0[12],P0[13], pw1[0]=PKW(P0,8), pw1[1]=PKW(P0,10), pw1); \
    VRD(5); SBAR(); GAPA(C1=__builtin_amdgcn_mfma_f32_32x32x16_bf16(kf[3],qr[1],C1,0,0,0),   P0[14],P0[15],P1[0],P1[1],   pw1[2]=PKW(P0,12),pw1[3]=PKW(P0,14), pw1); \
    VRD(2); SBAR(); GAPA(C0=__builtin_amdgcn_mfma_f32_32x32x16_bf16(kf[4],qr[2],C0,0,0,0),   P1[2],P1[3],P1[4],P1[5],     pw2[0]=PKW(P1,0), pw2[1]=PKW(P1,2), pw2); \
    VRD(6); SBAR(); GAPA(C1=__builtin_amdgcn_mfma_f32_32x32x16_bf16(kf[5],qr[2],C1,0,0,0),   P1[6],P1[7],P1[8],P1[9],     pw2[2]=PKW(P1,4), pw2[3]=PKW(P1,6), pw2); \
    VRD(3); SBAR(); GAPA(C0=__builtin_amdgcn_mfma_f32_32x32x16_bf16(kf[6],qr[3],C0,0,0,0),   P1[10],P1[11],P1[12],P1[13], pw3[0]=PKW(P1,8), pw3[1]=PKW(P1,10), pw3); \
    VRD(7); SBAR(); GAPA(C1=__builtin_amdgcn_mfma_f32_32x32x16_bf16(kf[7],qr[3],C1,0,0,0),   P1[14],P1[15],0.f,0.f,       pw3[2]=PKW(P1,12),pw3[3]=PKW(P1,14), pw3); \
    l_reg+=sacc; \
    if(GK){DMA_K((t)+3,sl_cur);} if(GV){DMA_V((t)+1,sl_next);} \
    CMASK(C0,C1,t); \
    { float a=MX3(C0[0],C0[1],C1[0]),b=MX3(C0[2],C0[3],C1[1]); a=MX3(a,C1[2],C1[3]); \
      _Pragma("unroll") for(int r=4;r<16;r+=4){a=MX3(a,C0[r],C0[r+1]);b=MX3(b,C0[r+2],C0[r+3]);a=MX3(a,C1[r],C1[r+1]);b=MX3(b,C1[r+2],C1[r+3]);} \
      float rm=__builtin_fmaxf(a,b); { auto rr=__builtin_amdgcn_permlane32_swap(__float_as_uint(rm),__float_as_uint(rm),false,false); rm=__builtin_fmaxf(__uint_as_float(rr[0]),__uint_as_float(rr[1])); } \
      resc=false; \
      if(__builtin_expect(__any(rm>(float)THRL),0)){ const float dl=__builtin_fmaxf(rm,0.f); mhat+=dl; \
        _Pragma("unroll") for(int r=0;r<16;++r){C0[r]-=dl;C1[r]-=dl;} \
        SETQX(cq-mhat); \
        const float f=__builtin_amdgcn_exp2f(-dl); l_reg*=f; if(hi==0)wsf[r32]=f; resc=true; } } \
    SBAR(); \
    GAPB(o[0]=__builtin_amdgcn_mfma_f32_32x32x16_bf16(PAF(0),VFR(0),o[0],0,0,0), C0,0); \
    GAPB(o[1]=__builtin_amdgcn_mfma_f32_32x32x16_bf16(PAF(0),VFR(4),o[1],0,0,0), C0,4); \
    KRD(GL,0); GAPB(o[0]=__builtin_amdgcn_mfma_f32_32x32x16_bf16(PAF(1),VFR(1),o[0],0,0,0), C0,8); \
    KRD(GL,1); GAPB(o[1]=__builtin_amdgcn_mfma_f32_32x32x16_bf16(PAF(1),VFR(5),o[1],0,0,0), C0,12); \
    KRD(GL,2); GAPB(o[0]=__builtin_amdgcn_mfma_f32_32x32x16_bf16(PAF(2),VFR(2),o[0],0,0,0), C1,0); \
    KRD(GL,3); GAPB(o[1]=__builtin_amdgcn_mfma_f32_32x32x16_bf16(PAF(2),VFR(6),o[1],0,0,0), C1,4); \
    GAPB(o[0]=__builtin_amdgcn_mfma_f32_32x32x16_bf16(PAF(3),VFR(3),o[0],0,0,0), C1,8); \
    GAPB(o[1]=__builtin_amdgcn_mfma_f32_32x32x16_bf16(PAF(3),VFR(7),o[1],0,0,0), C1,12); \
    }while(0)
  int t=1; KXLOAD(TILE(1));
  #undef CMASK
  #define CMASK(P0,P1,t) do{}while(0)
  for(;t+5<NT;t+=2){
    STEP(pB0,pB1,pA0,pA1,t,true,true,true);     WAIT_BAR(2); RESC(); ROT();
    STEP(pA0,pA1,pB0,pB1,t+1,true,true,true);   WAIT_BAR(2); RESC(); ROT();
  }
  #undef CMASK
  #define CMASK(P0,P1,t) do{int jb_=(t)-(NT-4); if(jb_>=0)cmask(P0,P1,jb_,qrel,hi);}while(0)
  #define ENDW(tt) do{ if((tt)+3<NT){WAIT_BAR(2);} else if((tt)+2<NT){WAIT_BAR(1);} else {WAIT_BAR(0);} }while(0)
  for(;t+1<NT;t+=2){
    STEP(pB0,pB1,pA0,pA1,t,(t+3<NT),(t+1<NT),(t+1<NT));       ENDW(t);   RESC(); ROT();
    STEP(pA0,pA1,pB0,pB1,t+1,(t+4<NT),(t+2<NT),(t+2<NT));     ENDW(t+1); RESC(); ROT();
  }
  STEP(pB0,pB1,pA0,pA1,NT-1,false,false,false); RESC();
  { float sacc=pB0[0]+pB0[1]; _Pragma("unroll") for(int r=2;r<16;++r)sacc+=pB0[r]; _Pragma("unroll") for(int r=0;r<16;++r)sacc+=pB1[r]; l_reg+=sacc;
    pw0=(u32x4){PKW(pB0,0),PKW(pB0,2),PKW(pB0,4),PKW(pB0,6)};pw1=(u32x4){PKW(pB0,8),PKW(pB0,10),PKW(pB0,12),PKW(pB0,14)};pw2=(u32x4){PKW(pB1,0),PKW(pB1,2),PKW(pB1,4),PKW(pB1,6)};pw3=(u32x4){PKW(pB1,8),PKW(pB1,10),PKW(pB1,12),PKW(pB1,14)};
    SBAR(); pv(o,vb0+sl_cur,PAF(0),PAF(1),PAF(2),PAF(3)); }
  #undef PKW
  #undef PAF
  #undef VFR
  #undef PIN
  #undef MX3
  #undef GAPA
  #undef GAPB
  #undef EX
  #undef VRD
  #undef KRD
  #undef STEP
  #undef ENDW
  {auto rr=__builtin_amdgcn_permlane32_swap(__float_as_uint(l_reg),__float_as_uint(l_reg),false,false);l_reg=__uint_as_float(rr[0])+__uint_as_float(rr[1]);}
  if(hi==0)wsf[32+r32]=l_reg;asm volatile("s_waitcnt lgkmcnt(0)":::"memory");
  float rli[16];
  #pragma unroll
  for(int r=0;r<16;++r)rli[r]=__builtin_amdgcn_rcpf(wsf[32+crow(r,hi)]);
  bf16*Ow=O+(rowbase+q0+wid*QBLK)*OPITCH+h*D;
  { bf16*stg=(bf16*)(shm+LDS_OST)+wid*2048;
    #pragma unroll
    for(int r=0;r<16;++r){const int orow=crow(r,hi);
      #pragma unroll
      for(int d0=0;d0<2;++d0)stg[orow*64+d0*32+r32]=__float2bfloat16(o[d0][r]*rli[r]);}
    asm volatile("s_waitcnt lgkmcnt(0)":::"memory");
    #pragma unroll
    for(int i=0;i<4;++i){const int row=i*8+(lane>>3),ch=lane&7; const u32x4 v=*(const u32x4*)(stg+row*64+ch*8); ATTN_STORE16(Ow+(long)row*OPITCH+ch*8,v);} }
  asm volatile("s_waitcnt lgkmcnt(0)\n\ts_barrier":::"memory");
  #undef DMA_K
  #undef DMA_V
  #undef SETQX
  #undef KXF
  #undef BIAS0
  #undef BIASP
  #undef KXLOAD
  #undef TILE
  #undef CMASK
  #undef START
  #undef RESC
  #undef ROT
}
constexpr int ATTN_LDS_BYTES=LDS_BYTES;
struct AttnTensors { const bf16* Q; const bf16* K; const bf16* V; bf16* O; };
struct AttnUnit { int bh; int qb; };
struct StaticOrder {
  int vcu;
  __device__ __forceinline__ explicit StaticOrder(int grid,int block):vcu((block%8)*(grid/8)+block/8){}
  __device__ __forceinline__ bool next(int i,AttnUnit&u)const{ if(i>=2)return false; const int s=vcu&7; u.bh=vcu>>3; u.qb=(i==0)?s:15-s; return true; }
  __device__ __forceinline__ void a_ready(const AttnUnit&)const{}
  __device__ __forceinline__ void done(const AttnUnit&)const{}
};
template<class Sched,int THRL=8> __device__ __forceinline__ void attn_phase(char*lds,const AttnTensors&T,const float*lft,const Sched&S){
  AttnUnit u;
  if(!S.next(0,u))return;
  __syncthreads();
  { int tid_=threadIdx.x; asm volatile("":"+v"(tid_)); const int tid=tid_,lane=tid&63,wid=tid>>6; typedef float f32x4_t __attribute__((ext_vector_type(4)));
    const float*src=lft+(long)u.bh*SEQ+tid*8; const f32x4_t a=*(const f32x4_t*)src,b=*(const f32x4_t*)(src+4);
    float v[8]={a[0],a[1],a[2],a[3],b[0],b[1],b[2],b[3]};
    #pragma unroll
    for(int j=1;j<8;++j)v[j]+=v[j-1];
    float sc=v[7];
    #pragma unroll
    for(int o=1;o<64;o<<=1){const float t=__shfl_up(sc,o);if(lane>=o)sc+=t;}
    __attribute__((address_space(3))) float*wsum=(__attribute__((address_space(3))) float*)(lds+LDS_WS);
    typedef unsigned u32x2_t __attribute__((ext_vector_type(2)));
    __attribute__((address_space(3))) u32x2_t*ct=(__attribute__((address_space(3))) u32x2_t*)(lds+LDS_CUM);
    if(lane==63)wsum[wid]=sc;
    __syncthreads();
    float off=sc-v[7];
    for(int w=0;w<wid;++w)off+=wsum[w];
    #pragma unroll
    for(int j=0;j<8;++j){ const float c=(off+v[j])*1.4426950408889634f; const float hf=__uint_as_float(cvtpk_s(c,0.f)<<16), r1=c-hf, mf=__uint_as_float(cvtpk_s(r1,0.f)<<16), r2=r1-mf;
      u32x2_t e; e[0]=cvtpk_s(-hf,-mf); e[1]=cvtpk_s(-r2,1.0f); ct[tid*8+j]=e; }
    if(tid==0){ unsigned zz=0u; asm volatile("":"+v"(zz)); u32x2_t z; z[0]=zz; z[1]=zz; ct[SEQ]=z; }
    __syncthreads(); }
  for(int i=0;S.next(i,u);++i){ S.a_ready(u); attn_unit<THRL>(u.bh/NHEAD,u.bh%NHEAD,u.qb,T.Q,T.K,T.V,T.O,lds); S.done(u); }
}
#undef SBAR
#undef WAIT_BAR
}
namespace ret {
typedef short bf16x8 __attribute__((ext_vector_type(8)));
typedef short s16x4 __attribute__((ext_vector_type(4)));
typedef float f32x16 __attribute__((ext_vector_type(16)));
typedef float f32x4 __attribute__((ext_vector_type(4)));
typedef unsigned u32x4 __attribute__((ext_vector_type(4)));
typedef unsigned u32x2 __attribute__((ext_vector_type(2)));
typedef LAS const char* lds_cptr;
constexpr int CH = 128;
__device__ __forceinline__ int offb(int row, int ch) { return 256 * row + 16 * (ch ^ (((row & 3) << 2) | ((row >> 2) & 3))); }
__device__ __forceinline__ s16x4 vtr(lds_cptr p) { return __builtin_bit_cast(s16x4, __builtin_amdgcn_ds_read_tr16_b64_v4i16((LAS s16x4*)p)); }
__device__ __forceinline__ bf16x8 tr_frag(lds_cptr img, int Ra, int Rb, int C0blk, int lane) {
    const int q = (lane & 15) >> 2, p = lane & 3, c = ((C0blk + 16 * ((lane >> 4) & 1)) >> 3) + (p >> 1), hb = 8 * (p & 1);
    const s16x4 lo = vtr(img + offb(Ra + q, c) + hb), hi = vtr(img + offb(Rb + q, c) + hb);
    return (bf16x8){lo[0], lo[1], lo[2], lo[3], hi[0], hi[1], hi[2], hi[3]};
}
__device__ __forceinline__ unsigned cvt_pk(float lo, float hi) { unsigned r; asm volatile("v_cvt_pk_bf16_f32 %0, %1, %2" : "=v"(r) : "v"(lo), "v"(hi)); return r; }
__device__ __forceinline__ float lo16(unsigned w) { return __uint_as_float(w << 16); }
__device__ __forceinline__ float hi16(unsigned w) { return __uint_as_float(w & 0xffff0000u); }
__device__ __forceinline__ void store_wt16(bf16_t* p, unsigned v) { asm volatile("global_store_short %0, %1, off sc1" :: "v"(p), "v"(v) : "memory"); }
__device__ __forceinline__ void store_wt32u(unsigned* p, unsigned v) { asm volatile("global_store_dword %0, %1, off sc1" :: "v"(p), "v"(v) : "memory"); }
__device__ __forceinline__ void store_wt32(float* p, float v) { asm volatile("global_store_dword %0, %1, off sc1" :: "v"(p), "v"(v) : "memory"); }
__device__ __forceinline__ int crow(int r, int hi) { return (r & 3) + 8 * (r >> 2) + 4 * hi; }
__device__ __forceinline__ float log2_gamma(int h) { asm volatile("" : "+v"(h)); return log2f(1.f - exp2f(-5.f - (float)h)); }

template <bool SCALE> __device__ __forceinline__ void stage_bf16(LAS char* img, const bf16_t* src, int ld, int tid, float l2g) {
#pragma unroll
    for (int i = 0; i < 4; ++i) { const int c = tid + 512 * i, row = c >> 4, ch = c & 15;
        u32x4 v = *(const u32x4*)(src + (size_t)row * ld + ch * 8);
        if (SCALE) { const float z = exp2f(l2g * (float)(127 - row));
            v.x = cvt_pk(lo16(v.x) * z, hi16(v.x) * z); v.y = cvt_pk(lo16(v.y) * z, hi16(v.y) * z); v.z = cvt_pk(lo16(v.z) * z, hi16(v.z) * z); v.w = cvt_pk(lo16(v.w) * z, hi16(v.w) * z); }
        *(LAS u32x4*)(img + offb(row, ch)) = v; }
}
__device__ __forceinline__ void stage_f32(LAS char* img, const float* src, int tid) {
#pragma unroll
    for (int i = 0; i < 4; ++i) { const int c = tid + 512 * i, row = c >> 4, ch = c & 15;
        const f32x4 a = *(const f32x4*)(src + row * 128 + ch * 8), b = *(const f32x4*)(src + row * 128 + ch * 8 + 4);
        u32x4 v; v.x = cvt_pk(a[0], a[1]); v.y = cvt_pk(a[2], a[3]); v.z = cvt_pk(b[0], b[1]); v.w = cvt_pk(b[2], b[3]);
        *(LAS u32x4*)(img + offb(row, ch)) = v; }
}

__device__ __forceinline__ void stage_ld_bf16(u32x4 (&v)[4], const bf16_t* src, int ld, int tid) {
#pragma unroll
    for (int i = 0; i < 4; ++i) { const int c = tid + 512 * i, row = c >> 4, ch = c & 15; v[i] = *(const u32x4*)(src + (size_t)row * ld + ch * 8); }
}
template <bool SCALE> __device__ __forceinline__ void stage_wr_bf16(LAS char* img, u32x4 (&v)[4], int tid, float l2g) {
#pragma unroll
    for (int i = 0; i < 4; ++i) { const int c = tid + 512 * i, row = c >> 4, ch = c & 15;
        if (SCALE) { const float z = exp2f(l2g * (float)(127 - row));
            v[i].x = cvt_pk(lo16(v[i].x) * z, hi16(v[i].x) * z); v[i].y = cvt_pk(lo16(v[i].y) * z, hi16(v[i].y) * z); v[i].z = cvt_pk(lo16(v[i].z) * z, hi16(v[i].z) * z); v[i].w = cvt_pk(lo16(v[i].w) * z, hi16(v[i].w) * z); }
        *(LAS u32x4*)(img + offb(row, ch)) = v[i]; }
}
__device__ __forceinline__ void stage_ld_f32(f32x4 (&v)[8], const float* src, int tid) {
#pragma unroll
    for (int i = 0; i < 4; ++i) { const int c = tid + 512 * i, row = c >> 4, ch = c & 15; v[2 * i] = *(const f32x4*)(src + row * 128 + ch * 8); v[2 * i + 1] = *(const f32x4*)(src + row * 128 + ch * 8 + 4); }
}
__device__ __forceinline__ void stage_wr_f32(LAS char* img, const f32x4 (&v)[8], int tid) {
#pragma unroll
    for (int i = 0; i < 4; ++i) { const int c = tid + 512 * i, row = c >> 4, ch = c & 15;
        u32x4 w; w.x = cvt_pk(v[2 * i][0], v[2 * i][1]); w.y = cvt_pk(v[2 * i][2], v[2 * i][3]); w.z = cvt_pk(v[2 * i + 1][0], v[2 * i + 1][1]); w.w = cvt_pk(v[2 * i + 1][2], v[2 * i + 1][3]);
        *(LAS u32x4*)(img + offb(row, ch)) = w; }
}

template <int NU> __device__ __forceinline__ void retkv_units(int id0, int idstep, const bf16_t* KR, const bf16_t* VR, bf16_t* KVS, LAS char* lds) {
    int tid_ = threadIdx.x; asm volatile("" : "+v"(tid_));
    const int tid = tid_, lane = tid & 63, wid = __builtin_amdgcn_readfirstlane(tid >> 6), hi = lane >> 5;
    __syncthreads();
    u32x4 kv_[NU][4], vv_[NU][4];
#pragma unroll
    for (int u = 0; u < NU; ++u) { const int id = id0 + u * idstep, bh = id >> 5, n = id & 31, b = bh >> 2, h = bh & 3;
        const size_t rowbase = (size_t)(b * SEQ + n * CH) * 512 + h * 128;
        stage_ld_bf16(kv_[u], KR + rowbase, 512, tid); stage_ld_bf16(vv_[u], VR + rowbase, 512, tid); }
#pragma unroll
    for (int u = 0; u < NU; ++u) { const int id = id0 + u * idstep, h = (id >> 5) & 3;
        stage_wr_bf16<true>(lds + u * 65536, kv_[u], tid, log2_gamma(h)); stage_wr_bf16<false>(lds + u * 65536 + 32768, vv_[u], tid, 0.f); }
    __syncthreads();
    const int mb = wid >> 1, nb0 = 2 * (wid & 1);
#pragma unroll
    for (int u = 0; u < NU; ++u) {
        const lds_cptr Kimg = lds + u * 65536, Vimg = Kimg + 32768;
        f32x16 acc0 = {}, acc1 = {};
#pragma unroll
        for (int s = 0; s < 8; ++s) {
            const int Ra = 16 * s + 8 * hi;
            const bf16x8 A = tr_frag(Kimg, Ra, Ra + 4, 32 * mb, lane);
            const bf16x8 B0 = tr_frag(Vimg, Ra, Ra + 4, 32 * nb0, lane), B1 = tr_frag(Vimg, Ra, Ra + 4, 32 * nb0 + 32, lane);
            acc0 = __builtin_amdgcn_mfma_f32_32x32x16_bf16(A, B0, acc0, 0, 0, 0);
            acc1 = __builtin_amdgcn_mfma_f32_32x32x16_bf16(A, B1, acc1, 0, 0, 0);
        }
        bf16_t* out = KVS + (size_t)(id0 + u * idstep) * 16384 + 32 * nb0 + (lane & 31);
#pragma unroll
        for (int r = 0; r < 16; ++r) { const int dk = 32 * mb + crow(r, hi);
            const float n0 = __shfl_xor(acc0[r], 1), n1 = __shfl_xor(acc1[r], 1);
            if (!(lane & 1)) { store_wt32u((unsigned*)(out + dk * 128), cvt_pk(acc0[r], n0)); store_wt32u((unsigned*)(out + dk * 128 + 32), cvt_pk(acc1[r], n1)); } }
    }
}

__device__ __forceinline__ void ret_scan_pair(unsigned* KVS32, int bh, int q) {
    const float gc = exp2f(128.f * log2_gamma(bh & 3));
    unsigned* p = KVS32 + (size_t)bh * 32 * 8192 + q; float p0 = 0.f, p1 = 0.f; unsigned t[32];
#pragma unroll
    for (int j = 0; j < 32; ++j) t[j] = p[(size_t)j * 8192];
    asm volatile("s_waitcnt vmcnt(0)" : "+v"(t[0]), "+v"(t[1]), "+v"(t[2]), "+v"(t[3]), "+v"(t[4]), "+v"(t[5]), "+v"(t[6]), "+v"(t[7]), "+v"(t[8]), "+v"(t[9]), "+v"(t[10]), "+v"(t[11]), "+v"(t[12]), "+v"(t[13]), "+v"(t[14]), "+v"(t[15]) :: "memory");
    asm volatile("s_waitcnt vmcnt(0)" : "+v"(t[16]), "+v"(t[17]), "+v"(t[18]), "+v"(t[19]), "+v"(t[20]), "+v"(t[21]), "+v"(t[22]), "+v"(t[23]), "+v"(t[24]), "+v"(t[25]), "+v"(t[26]), "+v"(t[27]), "+v"(t[28]), "+v"(t[29]), "+v"(t[30]), "+v"(t[31]) :: "memory");
#pragma unroll
    for (int j = 0; j < 32; ++j) { store_wt32u(p + (size_t)j * 8192, cvt_pk(p0, p1)); p0 = gc * p0 + lo16(t[j]); p1 = gc * p1 + hi16(t[j]); }
}
__device__ __forceinline__ void ret_scan(bf16_t* KVS, int gtid, int nthreads) {
    for (int idx = gtid; idx < 16 * 8192; idx += nthreads) ret_scan_pair((unsigned*)KVS, idx >> 13, idx & 8191);
}
__device__ __forceinline__ void ret_scan_slice(bf16_t* KVS, int bh, int c16, int tid) {
    ret_scan_pair((unsigned*)KVS, bh, c16 * 512 + tid);
}

__device__ __forceinline__ void retout_unit(int bh, int cp, const bf16_t* QR, bf16_t* RO, const bf16_t* KR, const bf16_t* VR, const bf16_t* GR, const bf16_t* KVS, const float* retnorm, LAS char* lds) {
    int tid_ = threadIdx.x; asm volatile("" : "+v"(tid_));
    const int tid = tid_, lane = tid & 63, wid = __builtin_amdgcn_readfirstlane(tid >> 6), hi = lane >> 5, r32 = lane & 31;
    const int b = bh >> 2, h = bh & 3; const float l2g = log2_gamma(h);
    const int c = wid >> 2, qb = wid & 3, n = 2 * cp + c;
    const size_t chunk0 = (size_t)(b * SEQ + n * CH);
    const size_t qoff = (chunk0 + 32 * qb + r32) * 512 + h * 128;
    bf16x8 qf[8]; u32x2 gt[4][4];
#pragma unroll
    for (int s = 0; s < 8; ++s) qf[s] = *(const bf16x8*)(QR + qoff + 16 * s + 8 * hi);
#pragma unroll
    for (int t = 0; t < 4; ++t)
#pragma unroll
        for (int g = 0; g < 4; ++g) gt[t][g] = *(const u32x2*)(GR + qoff + 32 * t + 8 * g + 4 * hi);
    const bf16_t* kp0 = KR + (chunk0 + r32) * 512 + h * 128 + 8 * hi;
    bf16x8 kf[8];
#pragma unroll
    for (int s = 0; s < 8; ++s) kf[s] = *(const bf16x8*)(kp0 + 16 * s);
    asm volatile("s_waitcnt lgkmcnt(0)\n\ts_barrier" ::: "memory");
    { u32x4 vv_[2][4], sv_[2][4];
#pragma unroll
      for (int cc = 0; cc < 2; ++cc) { const int nn = 2 * cp + cc;
          stage_ld_bf16(vv_[cc], VR + (size_t)(b * SEQ + nn * CH) * 512 + h * 128, 512, tid); stage_ld_bf16(sv_[cc], KVS + ((size_t)bh * 32 + nn) * 16384, 128, tid); }
#pragma unroll
      for (int cc = 0; cc < 2; ++cc) { stage_wr_bf16<false>(lds + cc * 65536, vv_[cc], tid, 0.f); stage_wr_bf16<false>(lds + cc * 65536 + 32768, sv_[cc], tid, 0.f); } }
    __syncthreads();
    const lds_cptr Vimg = lds + c * 65536, Simg = Vimg + 32768;
    f32x16 o[4];
#pragma unroll
    for (int t = 0; t < 4; ++t) { o[t] = f32x16{};
#pragma unroll
        for (int s = 0; s < 8; ++s) { const int Ra = 16 * s + 8 * hi; o[t] = __builtin_amdgcn_mfma_f32_32x32x16_bf16(tr_frag(Simg, Ra, Ra + 4, 32 * t, lane), qf[s], o[t], 0, 0, 0); } }
    { const float xi = exp2f(l2g * (float)(32 * qb + r32 + 1));
#pragma unroll
      for (int t = 0; t < 4; ++t)
#pragma unroll
          for (int r = 0; r < 16; ++r) o[t][r] *= xi; }
    for (int jb = 0; jb <= qb; ++jb) {
        f32x16 p = {};
        bf16x8 kn[8];
        const bf16_t* kpn = kp0 + (size_t)(jb < qb ? 32 * (jb + 1) : 0) * 512;
#pragma unroll
        for (int s = 0; s < 8; ++s) kn[s] = *(const bf16x8*)(kpn + 16 * s);
#pragma unroll
        for (int s = 0; s < 8; ++s) p = __builtin_amdgcn_mfma_f32_32x32x16_bf16(kf[s], qf[s], p, 0, 0, 0);
        const int dij = 32 * (qb - jb) + r32;
#pragma unroll
        for (int r = 0; r < 16; ++r) { const int d = dij - crow(r, hi); p[r] = d >= 0 ? p[r] * exp2f(l2g * (float)d) : 0.f; }
        u32x4 w0, w1; w0.x = cvt_pk(p[0], p[1]); w0.y = cvt_pk(p[2], p[3]); w0.z = cvt_pk(p[4], p[5]); w0.w = cvt_pk(p[6], p[7]);
        w1.x = cvt_pk(p[8], p[9]); w1.y = cvt_pk(p[10], p[11]); w1.z = cvt_pk(p[12], p[13]); w1.w = cvt_pk(p[14], p[15]);
        const bf16x8 pb0 = __builtin_bit_cast(bf16x8, w0), pb1 = __builtin_bit_cast(bf16x8, w1);
#pragma unroll
        for (int t = 0; t < 4; ++t) {
            const int R0 = 32 * jb + 4 * hi;
            o[t] = __builtin_amdgcn_mfma_f32_32x32x16_bf16(tr_frag(Vimg, R0, R0 + 8, 32 * t, lane), pb0, o[t], 0, 0, 0);
            o[t] = __builtin_amdgcn_mfma_f32_32x32x16_bf16(tr_frag(Vimg, R0 + 16, R0 + 24, 32 * t, lane), pb1, o[t], 0, 0, 0);
        }
#pragma unroll
        for (int s = 0; s < 8; ++s) kf[s] = kn[s];
    }
    f32x4 rn[4][4];
    { const GAS float* rnp = (const GAS float*)retnorm + h * 128 + 4 * hi; asm volatile("" : "+v"(rnp));
#pragma unroll
      for (int t = 0; t < 4; ++t)
#pragma unroll
          for (int g = 0; g < 4; ++g) rn[t][g] = *(const GAS f32x4*)(rnp + 32 * t + 8 * g); }
    float ss = 0.f;
#pragma unroll
    for (int t = 0; t < 4; ++t)
#pragma unroll
        for (int r = 0; r < 16; ++r) ss += o[t][r] * o[t][r];
    ss += __shfl_xor(ss, 32);
    const float rms = rsqrtf(ss * (1.f / 128.f) + 1e-6f);
#pragma unroll
    for (int t = 0; t < 4; ++t)
#pragma unroll
        for (int g = 0; g < 4; ++g) { const int dv0 = 32 * t + 8 * g + 4 * hi;
            u32x2 w; w.x = cvt_pk(lo16(gt[t][g].x) * o[t][4 * g] * rms * rn[t][g][0], hi16(gt[t][g].x) * o[t][4 * g + 1] * rms * rn[t][g][1]);
            w.y = cvt_pk(lo16(gt[t][g].y) * o[t][4 * g + 2] * rms * rn[t][g][2], hi16(gt[t][g].y) * o[t][4 * g + 3] * rms * rn[t][g][3]);
            *(u32x2*)(RO + (chunk0 + 32 * qb + r32) * 1024 + h * 128 + dv0) = w; }
}
}
#define XB_TMO      128
#define XB_XCNT(j)  (256  + 64 * (j))
#define XB_XSUB(j)  (1280 + 64 * (j))
#define XB_XGEN(j)  (2304 + 64 * (j))
#define XB_TOP      3328
#define XB_TOPGEN   3392
#define XCD_BAR_WORDS 3456
#define XB_SPIN_CAP (1u << 18)

__device__ __forceinline__ unsigned xb_ld(unsigned* p)              { return __hip_atomic_load(p, __ATOMIC_RELAXED, __HIP_MEMORY_SCOPE_AGENT); }
__device__ __forceinline__ unsigned xb_add(unsigned* p, unsigned v) { return __hip_atomic_fetch_add(p, v, __ATOMIC_RELAXED, __HIP_MEMORY_SCOPE_AGENT); }
__device__ __forceinline__ unsigned xb_xcc_id() { return (unsigned)__builtin_amdgcn_s_getreg((3 << 11) | 20) & 0xFu; }
#define XB_SPIN(cond, bar) do { unsigned _sp = 0; while (cond) { __builtin_amdgcn_s_sleep(1); \
    if ((++_sp & 255u) == 0u) { if (xb_ld(&(bar)[XB_TMO])) break; if (_sp > XB_SPIN_CAP) { atomicAdd(&(bar)[XB_TMO], 1u); break; } } } } while (0)

struct XcdBarrier {
    unsigned* bar; unsigned x;
    volatile LAS unsigned* st;
};

__device__ __forceinline__ XcdBarrier xcd_barrier_post(unsigned* bar, volatile LAS unsigned* st) {
    XcdBarrier b; b.bar = bar; b.x = xb_xcc_id(); b.st = st;
    if (threadIdx.x == 0) (void)xb_add(&bar[XB_XCNT(b.x)], 1u);
    return b;
}
__device__ __forceinline__ void xcd_barrier_complete(unsigned* bar, unsigned x, unsigned& nloc, unsigned& nx) {
    const unsigned G = gridDim.x * gridDim.y * gridDim.z;
    unsigned sum, cnt, mine, sp = 0u;
    for (;;) {
        sum = 0u; cnt = 0u; mine = 0u;
#pragma unroll
        for (unsigned j = 0; j < 16; ++j) { const unsigned c = xb_ld(&bar[XB_XCNT(j)]); sum += c; cnt += (c > 0u) ? 1u : 0u; mine = (j == x) ? c : mine; }
        if (sum == G) break;
        __builtin_amdgcn_s_sleep(1);
        if ((++sp & 255u) == 0u) { if (xb_ld(&bar[XB_TMO])) break; if (sp > XB_SPIN_CAP) { atomicAdd(&bar[XB_TMO], 1u); break; } }
    }
    nloc = mine > 0u ? mine : 1u; nx = cnt > 0u ? cnt : 1u;
}

__device__ __forceinline__ void xcd_barrier(const XcdBarrier& b) {
    asm volatile("s_waitcnt vmcnt(0)" ::: "memory");
    __syncthreads();
    if (threadIdx.x == 0) {
        unsigned* bar = b.bar;
        __builtin_amdgcn_s_waitcnt(0);
        unsigned nloc = b.st[0], nx = b.st[1];
        if (nloc == 0u) { xcd_barrier_complete(bar, b.x, nloc, nx); b.st[0] = nloc; b.st[1] = nx; }
        const unsigned old = xb_add(&bar[XB_XSUB(b.x)], 1u);
        const unsigned gen = old / nloc;
        if (old + 1u == (gen + 1u) * nloc) {
            __builtin_amdgcn_fence(__ATOMIC_RELEASE, "agent");
            asm volatile("s_waitcnt vmcnt(0)" ::: "memory");
            const unsigned og = xb_add(&bar[XB_TOP], 1u);
            const unsigned tg = og / nx;
            if (og + 1u == (tg + 1u) * nx) xb_add(&bar[XB_TOPGEN], 1u);
            else XB_SPIN(xb_ld(&bar[XB_TOPGEN]) == tg, bar);
            __builtin_amdgcn_fence(__ATOMIC_ACQUIRE, "agent");
            xb_add(&bar[XB_XGEN(b.x)], 1u);
            asm volatile("s_waitcnt vmcnt(0)" ::: "memory");
        } else {
            XB_SPIN(xb_ld(&bar[XB_XGEN(b.x)]) == gen, bar);
            __builtin_amdgcn_fence(__ATOMIC_ACQUIRE, "agent");
            asm volatile("s_waitcnt vmcnt(0)" ::: "memory");
        }
    }
    __syncthreads();
}
constexpr int NWAVES = 8;
constexpr int RING_OFF = 0, RING_BYTES = 131072;
constexpr int LDSCTL_OFF = RING_BYTES, MISC_OFF = LDSCTL_OFF + 320;
constexpr int LDS_BYTES = 147456;
typedef GAS unsigned gu32;
typedef unsigned v4u __attribute__((ext_vector_type(4)));
typedef float f32x4 __attribute__((ext_vector_type(4)));
#define LDS_WAIT() asm volatile("s_waitcnt lgkmcnt(0)" ::: "memory")
#define VM_WAIT() asm volatile("s_waitcnt vmcnt(0)" ::: "memory")

struct Args { const float* in[15]; float* out; unsigned char* ws; int ph_lo, ph_hi, li, flags; };
enum { IN_X = 0, IN_NORM1, IN_W1IN, IN_W1OUT, IN_NORMMIX, IN_WIN, IN_BFORGET, IN_RETNORM, IN_WORET, IN_WOFOX, IN_WOUT, IN_NORM2, IN_W2IN, IN_W2OUT, IN_NORMFINAL };

struct Frame {
    LAS unsigned char* lds;
    volatile LAS unsigned* MISC;
    int wave, vcu, G;
};
__device__ __forceinline__ int tid_now() { int t = threadIdx.x; asm volatile("" : "+v"(t)); return t; }

__device__ __forceinline__ void cv_load(const float* W, int ldw, int srccol, int nvalid, const float* gain, int k0, int lane, float (&v)[32], f32x4 (&g)[2]) {
    const int n = lane & 31, nc = n < nvalid ? n : 0;
    int ldw_ = ldw; asm volatile("" : "+s"(ldw_));
    const unsigned voff = (unsigned)((lane >> 5) * ldw_ + nc);
    const float* rp = W + (size_t)k0 * ldw_ + srccol;
#pragma unroll
    for (int i = 0; i < 32; ++i) v[i] = __builtin_nontemporal_load(rp + (size_t)(2 * i) * ldw_ + voff);
    if (gain) { g[0] = *(const f32x4*)(gain + k0 + 8 * (lane & 7)); g[1] = *(const f32x4*)(gain + k0 + 8 * (lane & 7) + 4); }
    if (nvalid < 32) {
#pragma unroll
        for (int i = 0; i < 32; ++i) v[i] = n < nvalid ? v[i] : 0.f; }
}
__device__ __forceinline__ void cv_finish(float (&v)[32], const float* gain, const f32x4 (&g)[2], int Kp, bf16_t* WT, int drow0, int kd0, LAS float* scr, int lane) {
    const int n = lane & 31;
#pragma unroll
    for (int i = 0; i < 32; ++i) scr[(2 * i + (lane >> 5)) * 33 + n] = v[i];
    LDS_WAIT(); asm volatile("" ::: "memory");
    const int c = lane & 7;
#pragma unroll
    for (int j = 0; j < 4; ++j) { const int nn = (lane >> 3) + 8 * j; const LAS float* s = scr + (8 * c) * 33 + nn;
        f32x4 a = (f32x4){s[0 * 33], s[1 * 33], s[2 * 33], s[3 * 33]}, b = (f32x4){s[4 * 33], s[5 * 33], s[6 * 33], s[7 * 33]};
        if (gain) { a *= g[0]; b *= g[1]; }
        v4u o; o.x = pk2(a[0], a[1]); o.y = pk2(a[2], a[3]); o.z = pk2(b[0], b[1]); o.w = pk2(b[2], b[3]);
        __builtin_nontemporal_store(o, (GAS v4u*)(WT + (size_t)(drow0 + nn) * Kp + kd0 + 8 * c)); }
    LDS_WAIT(); asm volatile("" ::: "memory");
}
__device__ __forceinline__ int src_col32(int kind, int rho0, int& nvalid) {
    nvalid = 32;
    if (kind == 0) return rho0;
    const int pn = rho0 >> 8, bj = (rho0 >> 7) & 1, j = rho0 & 127;
    if (kind == 1) return (bj ? DFF : 0) + 128 * pn + j;
    if (pn < 4) return (pn < 2 ? C_RQ : C_RK) + (2 * (pn & 1) + (j >> 6)) * 128 + 64 * bj + (j & 63);
    if (pn < 14) return rho0;
    if (pn < 22) return (bj ? C_GF : C_GR) + 128 * (pn - 14) + j;
    nvalid = (rho0 == 22 * 256) ? 8 : 0; return C_FF;
}
constexpr int CI_1IN = (D / 64) * (2 * DFF / 32), CI_1OUT = (DFF / 64) * (D / 32), CI_IN = (D / 64) * (NIN / 32), CI_O = (512 / 64) * (D / 32), CI_OUT = (D / 64) * (D / 32);
constexpr int CI_LAYER = 2 * CI_1IN + 2 * CI_1OUT + CI_IN + 2 * CI_O + CI_OUT;
__device__ __forceinline__ void convert_mat(const float* W, int ldw, const float* gain, int K, int Kp, int koff, bf16_t* WT, int N, int kind, int off, int lo, int hi, int w, int nw, LAS float* scr, int lane) {
    const int nblk = N / 32, nitems = (K / 64) * nblk;
    int a = lo > off ? lo : off; const int b = hi < off + nitems ? hi : off + nitems;
    if (a >= b) return;
    { int r = (a - lo - w) % nw; if (r < 0) r += nw; if (r) a += nw - r; }
    for (int fi = a; fi < b; fi += nw) { const int it = fi - off, kb = it / nblk, nb = it % nblk; int nvalid; const int sc = src_col32(kind, 32 * nb, nvalid);
        float v[32]; f32x4 g[2]; cv_load(W, ldw, sc, nvalid, gain, 64 * kb, lane, v, g); cv_finish(v, gain, g, Kp, WT, 32 * nb, koff + 64 * kb, scr, lane); }
}
__device__ __forceinline__ void convert_layer_range(const float* const* in, unsigned char* ws, int l, int lo, int hi, int w, int nw, LAS float* scr, int lane) {
    unsigned char* wl = ws + WS_W + (size_t)l * W_LAYER; int off = 0;
    convert_mat(in[IN_W1IN] + (size_t)l * D * 2 * DFF, 2 * DFF, in[IN_NORM1] + l * D, D, D, 0, (bf16_t*)(wl + WO_1IN), 2 * DFF, 1, off, lo, hi, w, nw, scr, lane); off += CI_1IN;
    convert_mat(in[IN_W1OUT] + (size_t)l * DFF * D, D, nullptr, DFF, DFF, 0, (bf16_t*)(wl + WO_1OUT), D, 0, off, lo, hi, w, nw, scr, lane); off += CI_1OUT;
    convert_mat(in[IN_WIN] + (size_t)l * D * IN_COLS, IN_COLS, in[IN_NORMMIX] + l * D, D, D, 0, (bf16_t*)(wl + WO_IN), NIN, 2, off, lo, hi, w, nw, scr, lane); off += CI_IN;
    convert_mat(in[IN_WORET] + (size_t)l * 512 * D, D, nullptr, 512, 1024, 0, (bf16_t*)(wl + WO_OR), D, 0, off, lo, hi, w, nw, scr, lane); off += CI_O;
    convert_mat(in[IN_WOFOX] + (size_t)l * 512 * D, D, nullptr, 512, 1024, 512, (bf16_t*)(wl + WO_OR), D, 0, off, lo, hi, w, nw, scr, lane); off += CI_O;
    convert_mat(in[IN_WOUT] + (size_t)l * D * D, D, nullptr, D, D, 0, (bf16_t*)(wl + WO_OUT), D, 0, off, lo, hi, w, nw, scr, lane); off += CI_OUT;
    convert_mat(in[IN_W2IN] + (size_t)l * D * 2 * DFF, 2 * DFF, in[IN_NORM2] + l * D, D, D, 0, (bf16_t*)(wl + WO_2IN), 2 * DFF, 1, off, lo, hi, w, nw, scr, lane); off += CI_1IN;
    convert_mat(in[IN_W2OUT] + (size_t)l * DFF * D, D, nullptr, DFF, DFF, 0, (bf16_t*)(wl + WO_2OUT), D, 0, off, lo, hi, w, nw, scr, lane);
}
constexpr int CG_PRO = 5120, CG_A = 5120, CG_C = 2176;
static_assert(CI_LAYER == 12416 && CG_PRO + DEPTH * (2 * CG_A + CG_C) >= DEPTH * CI_LAYER, "conversion slots cover the list");
__device__ __forceinline__ void convert_global_range(const float* const* in, unsigned char* ws, int lo, int hi, int w, int nw, LAS float* scr, int lane) {
    if (hi > DEPTH * CI_LAYER) hi = DEPTH * CI_LAYER;
    for (int l = lo / CI_LAYER; l < DEPTH && l * CI_LAYER < hi; ++l) {
        const int a = lo - l * CI_LAYER, b = hi - l * CI_LAYER;
        convert_layer_range(in, ws, l, a > 0 ? a : 0, b < CI_LAYER ? b : CI_LAYER, w, nw, scr, lane);
    }
}
__device__ __forceinline__ int slot_start(int l, int which) { return CG_PRO + l * (2 * CG_A + CG_C) + (which == 0 ? 0 : which == 1 ? CG_A : CG_A + CG_C); }

#define NREP(bit) ((PROBE_DUP & (bit)) ? 2 : 1)
#ifndef PROBE_PHSEL
#define PROBE_PHSEL 0x7ff
#endif
#ifndef PROBE_BLOCK
#define PROBE_BLOCK 0
#endif
constexpr size_t WS_DUMMY = WS_END;
constexpr int PH_PER_LAYER = 10, PH_FINAL = 1 + DEPTH * PH_PER_LAYER, N_PHASES = PH_FINAL + 1;
__global__ void __launch_bounds__(NWAVES * 64, 2) mega(Args args) {
    extern __shared__ __attribute__((aligned(16))) unsigned char lds[];
    Frame F;
    F.lds = (LAS unsigned char*)lds;
    F.MISC = (volatile LAS unsigned*)(F.lds + MISC_OFF);
    F.wave = __builtin_amdgcn_readfirstlane((int)threadIdx.x >> 6);
    F.G = gridDim.x; { const int bx = blockIdx.x; F.vcu = (F.G % 8 == 0) ? (bx % 8) * (F.G / 8) + bx / 8 : bx; }
    unsigned char* ws = args.ws;
    gu32* ctl = (gu32*)(ws + WS_CTL);
    for (int u = threadIdx.x; u < (LDS_BYTES - LDSCTL_OFF) / 4; u += NWAVES * 64) ((LAS unsigned*)(F.lds + LDSCTL_OFF))[u] = 0u;
    __syncthreads();
    XcdBarrier bar = xcd_barrier_post((unsigned*)(ctl + CW_BAR) + args.li * XCD_BAR_WORDS, F.MISC + 8);
    const int lo = args.ph_lo, hi = args.ph_hi;
#define IN(k) (lo <= (k) && (k) < hi)
    if (PROBE_SPIN && threadIdx.x == 0) { F.MISC[16] = 0u; F.MISC[17] = (unsigned)__builtin_amdgcn_s_memrealtime(); }
#define SEAM(k) do { if (IN(k) && IN((k) + 1)) { unsigned t0_ = 0; if (PROBE_SPIN == 1) t0_ = (unsigned)__builtin_amdgcn_s_memrealtime(); xcd_barrier(bar); if (PROBE_DUP & 256) xcd_barrier(bar); \
        if (PROBE_SPIN && threadIdx.x == 0) { const unsigned t1_ = (unsigned)__builtin_amdgcn_s_memrealtime(); const int slot_ = (k) == 0 ? 10 : ((k) - 1) % PH_PER_LAYER; \
            if ((PROBE_PHSEL >> slot_) & 1) F.MISC[16] = F.MISC[16] + (PROBE_SPIN == 1 ? t1_ - t0_ : t1_ - F.MISC[17]); F.MISC[17] = t1_; } } } while (0)
    unsigned gseq = 0u;
#define GROUP_SEAM(k) do { if (IN(k) && IN((k) + 1)) { if (F.G == 256) { gseq += 4u; gu32* gc_ = ctl + CW_GRP + 64 * (8 * ((int)blockIdx.x & 7) + (((int)blockIdx.x >> 3) & 7)); \
            VM_WAIT(); __syncthreads(); \
            if (threadIdx.x == 0) { __hip_atomic_fetch_add(gc_, 1u, __ATOMIC_RELAXED, __HIP_MEMORY_SCOPE_AGENT); \
                for (unsigned sp_ = 0; __hip_atomic_load(gc_, __ATOMIC_RELAXED, __HIP_MEMORY_SCOPE_AGENT) < gseq && sp_ < (1u << 22); ++sp_) __builtin_amdgcn_s_sleep(1); \
                __builtin_amdgcn_fence(__ATOMIC_ACQUIRE, "agent"); VM_WAIT(); } \
            __syncthreads(); } else xcd_barrier(bar); } } while (0)
    float* x = args.out;
    float* part = (float*)(ws + WS_PART);
    bf16_t* XB = (bf16_t*)(ws + WS_XB); bf16_t* HB = (bf16_t*)(ws + WS_H);
    bf16_t* RF = (bf16_t*)((unsigned char*)args.out + 32 * MiB);
    const int gw = F.vcu * NWAVES + F.wave, NGW = F.G * NWAVES;

    if (IN(0)) for (int rep_ = 0; rep_ < NREP(128); ++rep_) {
        const int lane = tid_now() & 63;
        LAS float* scr = (LAS float*)(F.lds + RING_OFF + F.wave * 16384);
        convert_global_range(args.in, ws, 0, CG_PRO, gw, NGW, scr, lane);
        {
            float* cs = (float*)(ws + WS_COS); float* sn = (float*)(ws + WS_SIN);
            for (int idx = gw * 64 + lane; idx < SEQ * 64; idx += NGW * 64) { const int s = idx >> 6, i = idx & 63;
                const float inv = exp2f(-0.20762050593046014f * (float)i);
                const double rev = (double)s * (double)inv * 0.15915494309189535;
                const float fr = (float)(rev - floor(rev)); cs[idx] = __builtin_amdgcn_cosf(fr); sn[idx] = __builtin_amdgcn_sinf(fr); }
        }
        const float* xin = args.in[IN_X];
        for (int m0 = gw; m0 < M; m0 += 2 * NGW) {
            f32x4 v[2][4];
#pragma unroll
            for (int q = 0; q < 2; ++q) { const int m = m0 + q * NGW; if (m < M) { const GAS f32x4* xr = (const GAS f32x4*)(xin + (size_t)m * D) + lane;
#pragma unroll
                for (int j = 0; j < 4; ++j) v[q][j] = xr[64 * j]; } }
#pragma unroll
            for (int q = 0; q < 2; ++q) { const int m = m0 + q * NGW; if (m < M) { float s = 0.f;
#pragma unroll
                for (int j = 0; j < 4; ++j) { const unsigned w0 = pk2(v[q][j][0], v[q][j][1]), w1 = pk2(v[q][j][2], v[q][j][3]);
                    const float a0 = __uint_as_float(w0 << 16), a1 = __uint_as_float(w0 & 0xffff0000u), a2 = __uint_as_float(w1 << 16), a3 = __uint_as_float(w1 & 0xffff0000u); s += (a0 * a0 + a1 * a1) + (a2 * a2 + a3 * a3);
                    ((GAS unsigned long long*)(XB + (size_t)m * D))[lane + 64 * j] = (unsigned long long)w0 | ((unsigned long long)w1 << 32); }
                s = wave_sum(s);
                if (lane < 16) part[(size_t)m * 16 + lane] = lane == 0 ? s : 0.f; } }
        }
    }
    SEAM(0);

    for (int hl = 0; hl < 2 * DEPTH; ++hl) {
        const int l = hl >> 1, odd = hl & 1, pb = 1 + l * PH_PER_LAYER;
        unsigned char* wl = ws + WS_W + (size_t)l * W_LAYER;
        if (odd) {
        if (IN(pb + 2)) {
            pg8::Gemm g{XB, (const bf16_t*)(wl + WO_IN), M, NIN, D}; pg8::StaticOrder S; S.init(M, NIN, F.G, (int)blockIdx.x);
            pg8::RstdTab rt{part, (const LAS float*)(F.lds + LDSCTL_OFF + 1024), -1}; { pg8::Unit u0{0, 0}; (void)S.next(0, u0); rt.pm0 = u0.pm; pg8::rstd_fill(part, u0.pm, (LAS float*)(F.lds + LDSCTL_OFF + 1024), tid_now()); }
            pg8::EpiInproj E{rt, (const float*)(ws + WS_COS), (const float*)(ws + WS_SIN), args.in[IN_BFORGET] + l * FH, ws, (float*)(ws + WS_LFT)};
            pg8::gemm_phase<pg8::EpiInproj, pg8::StaticOrder, true, true>(F.lds + RING_OFF, g, S, E);
            if ((int)blockIdx.x >= 192) convert_global_range(args.in, ws, slot_start(l, 1), slot_start(l, 1) + CG_C, ((int)blockIdx.x - 192) * NWAVES + F.wave, 64 * NWAVES, (LAS float*)(F.lds + RING_OFF + F.wave * 16384), tid_now() & 63);
        }
        SEAM(pb + 2);
        if (IN(pb + 3)) {
            if (args.flags & 2) {
              if (F.G == 256) {
                const int bh_ = F.vcu >> 4, c_ = F.vcu & 15;
                ret::retkv_units<2>(bh_ * 32 + 2 * c_, 1, (const bf16_t*)(ws + WS_KR), (const bf16_t*)(ws + WS_VR), (bf16_t*)x, (LAS char*)(F.lds + RING_OFF));
#define BH_SYNC(which) do { gu32* gc_ = ctl + CW_GRP + 64 * (64 + 2 * bh_ + (which)); VM_WAIT(); __syncthreads(); \
                    if (threadIdx.x == 0) { __hip_atomic_fetch_add(gc_, 1u, __ATOMIC_RELAXED, __HIP_MEMORY_SCOPE_AGENT); const unsigned want_ = 16u * (unsigned)(l + 1); \
                        for (unsigned sp_ = 0; __hip_atomic_load(gc_, __ATOMIC_RELAXED, __HIP_MEMORY_SCOPE_AGENT) < want_ && sp_ < (1u << 22); ++sp_) __builtin_amdgcn_s_sleep(1); \
                        __builtin_amdgcn_fence(__ATOMIC_ACQUIRE, "agent"); VM_WAIT(); } \
                    __syncthreads(); } while (0)
                BH_SYNC(0);
                ret::ret_scan_slice((bf16_t*)x, bh_, c_, tid_now());
                BH_SYNC(1);
#undef BH_SYNC
              } else {
                ret::retkv_units<2>(F.vcu, 256, (const bf16_t*)(ws + WS_KR), (const bf16_t*)(ws + WS_VR), (bf16_t*)x, (LAS char*)(F.lds + RING_OFF));
                xcd_barrier(bar);
                ret::ret_scan((bf16_t*)x, F.vcu * (NWAVES * 64) + tid_now(), F.G * NWAVES * 64);
                xcd_barrier(bar);
              }
                for (int rep_ = NREP(16) - 1; rep_ >= 0; --rep_) for (int id = F.vcu; id < 256; id += F.G) ret::retout_unit(id >> 4, id & 15, (const bf16_t*)(ws + WS_QR), rep_ ? (bf16_t*)(ws + WS_DUMMY) : RF, (const bf16_t*)(ws + WS_KR), (const bf16_t*)(ws + WS_VR), (const bf16_t*)(ws + WS_GR),
                                                                                            (const bf16_t*)x, args.in[IN_RETNORM] + l * 512, (LAS char*)(F.lds + RING_OFF)); }
            if (args.flags & 1) for (int rep_ = NREP(8) - 1; rep_ >= 0; --rep_) { const fox::AttnTensors AT{(const fox::bf16*)(ws + WS_FQ), (const fox::bf16*)(ws + WS_FK), (const fox::bf16*)(ws + WS_FV), (fox::bf16*)(rep_ ? (bf16_t*)(ws + WS_DUMMY) : RF + 512)};
                unsigned pa0_ = 0; if (PROBE_SPIN == 5) pa0_ = (unsigned)__builtin_amdgcn_s_memrealtime();
                const fox::StaticOrder S((int)F.G, (int)blockIdx.x); fox::attn_phase<fox::StaticOrder>((char*)lds + RING_OFF, AT, (const float*)(ws + WS_LFT), S);
                if (PROBE_SPIN == 5 && threadIdx.x == 0) F.MISC[16] = F.MISC[16] + ((unsigned)__builtin_amdgcn_s_memrealtime() - pa0_); }
        }
        SEAM(pb + 3);
        if (IN(pb + 6)) {
            pg8::Gemm g{RF, (const bf16_t*)(wl + WO_OR), M, D, D}; pg8::StaticOrder S; S.init(M, D, F.G, (int)blockIdx.x);
            pg8::EpiGated E{(const bf16_t*)(ws + WS_GATER), (const bf16_t*)(ws + WS_GATEF), (bf16_t*)(ws + WS_MERGED)};
            for (int rep_ = 0; rep_ < NREP(32); ++rep_) pg8::gemm_phase<pg8::EpiGated, pg8::StaticOrder, true, true>(F.lds + RING_OFF, g, S, E);
        }
        GROUP_SEAM(pb + 6);
        if (IN(pb + 7)) {
            pg8::Gemm g{(const bf16_t*)(ws + WS_MERGED), (const bf16_t*)(wl + WO_OUT), M, D, D}; pg8::StaticOrder S; S.init(M, D, F.G, (int)blockIdx.x);
            { pg8::EpiResid E{XB, part, 1.f, 1.f}; pg8::gemm_phase<pg8::EpiResid, pg8::StaticOrder, true, true>(F.lds + RING_OFF, g, S, E); }
        }
        SEAM(pb + 7);
        }
        const int kin = pb + (odd ? 8 : 0), kout = kin + 1;
        if (IN(kin)) { pg8::Gemm g{XB, (const bf16_t*)(wl + (odd ? WO_2IN : WO_1IN)), M, 2 * DFF, D}; pg8::StaticOrder S; S.init(M, 2 * DFF, F.G, (int)blockIdx.x);
            pg8::RstdTab rt{part, (const LAS float*)(F.lds + LDSCTL_OFF + 1024), -1}; { pg8::Unit u0{0, 0}; (void)S.next(0, u0); rt.pm0 = u0.pm; pg8::rstd_fill(part, u0.pm, (LAS float*)(F.lds + LDSCTL_OFF + 1024), tid_now()); }
            pg8::EpiSwiglu E{HB, rt}; pg8::gemm_phase<pg8::EpiSwiglu, pg8::StaticOrder, true, true>(F.lds + RING_OFF, g, S, E);
            if ((int)blockIdx.x >= 128) convert_global_range(args.in, ws, slot_start(l, odd ? 2 : 0), slot_start(l, odd ? 2 : 0) + CG_A, ((int)blockIdx.x - 128) * NWAVES + F.wave, 128 * NWAVES, (LAS float*)(F.lds + RING_OFF + F.wave * 16384), tid_now() & 63); }
        GROUP_SEAM(kin);
        if (IN(kout)) { pg8::Gemm g{HB, (const bf16_t*)(wl + (odd ? WO_2OUT : WO_1OUT)), M, D, DFF}; pg8::StaticOrder S; S.init(M, D, F.G, (int)blockIdx.x);
            { pg8::EpiResid E{XB, part, 0.5f, 2.f}; pg8::gemm_phase<pg8::EpiResid, pg8::StaticOrder, true, true>(F.lds + RING_OFF, g, S, E); } }
        SEAM(kout);
    }
    if (IN(PH_FINAL)) {
        const float* g = args.in[IN_NORMFINAL]; const int lane = tid_now() & 63;
        f32x4 gg[4];
#pragma unroll
        for (int j = 0; j < 4; ++j) gg[j] = ((const GAS f32x4*)g)[lane + 64 * j];
        for (int m0 = gw; m0 < M; m0 += 2 * NGW) {
            float ps[2]; unsigned long long w[2][4];
#pragma unroll
            for (int q = 0; q < 2; ++q) { const int m = m0 + q * NGW; if (m < M) { ps[q] = lane < 16 ? part[(size_t)m * 16 + lane] : 0.f;
#pragma unroll
                for (int j = 0; j < 4; ++j) w[q][j] = ((const GAS unsigned long long*)(XB + (size_t)m * D))[lane + 64 * j]; } }
#pragma unroll
            for (int q = 0; q < 2; ++q) { const int m = m0 + q * NGW; if (m < M) {
                const float rstd = rsqrtf(wave_sum(ps[q]) * (1.f / D) + EPS);
                GAS f32x4* xr = (GAS f32x4*)(x + (size_t)m * D) + lane;
#pragma unroll
                for (int j = 0; j < 4; ++j) { const unsigned w0 = (unsigned)w[q][j], w1 = (unsigned)(w[q][j] >> 32);
                    const f32x4 v = (f32x4){__uint_as_float(w0 << 16), __uint_as_float(w0 & 0xffff0000u), __uint_as_float(w1 << 16), __uint_as_float(w1 & 0xffff0000u)}; xr[64 * j] = v * rstd * gg[j]; } } }
        }
    }
    if (PROBE_SPIN && blockIdx.x == PROBE_BLOCK && threadIdx.x == 0) { const unsigned long long te = __builtin_amdgcn_s_memrealtime(), w = 8ull * F.MISC[16]; while (__builtin_amdgcn_s_memrealtime() - te < w) __builtin_amdgcn_s_sleep(8); }
#undef IN
#undef SEAM
}
#ifndef SLOW_MIXER
#define SLOW_MIXER 0
#endif
extern "C" void kernel_launch(void* const* d_in, const int* in_sizes, int n_in, void* d_out, int out_size, void* d_ws, size_t ws_size, hipStream_t stream) {
    static int grid = 0;
    if (grid == 0) {
        if (n_in != 15 || out_size != M * D || ws_size < WS_END + (PROBE_DUP ? 32 * MiB : 0)) { fprintf(stderr, "kernel_launch: unexpected shapes (n_in %d out %d ws %zu, need %zu)\n", n_in, out_size, ws_size, (size_t)WS_END); grid = -1; return; }
        int dev = 0, cus = 0, per_cu = 0;
        if (hipGetDevice(&dev) != hipSuccess || hipDeviceGetAttribute(&cus, hipDeviceAttributeMultiprocessorCount, dev) != hipSuccess) { grid = -1; return; }
        if (hipFuncSetAttribute((const void*)mega, hipFuncAttributeMaxDynamicSharedMemorySize, LDS_BYTES) != hipSuccess) { fprintf(stderr, "kernel_launch: hipFuncSetAttribute failed\n"); grid = -1; return; }
        if (hipOccupancyMaxActiveBlocksPerMultiprocessor(&per_cu, (const void*)mega, NWAVES * 64, LDS_BYTES) != hipSuccess || per_cu < 1) { fprintf(stderr, "kernel_launch: occupancy query says %d\n", per_cu); }
        (void)hipGetLastError();
        grid = cus;
        if (grid != 256) { fprintf(stderr, "kernel_launch: built for a 256-CU device (the attention / retention unit deals assume 256 workgroups), found %d\n", cus); grid = -1; return; }
    }
    if (grid < 0) return;
    unsigned char* ws = (unsigned char*)d_ws;
    (void)hipMemsetAsync(ws + WS_CTL, 0, CTL_BYTES, stream);
    Args a{};
    for (int i = 0; i < 15; ++i) a.in[i] = (const float*)d_in[i];
    a.out = (float*)d_out; a.ws = ws;
    int li = 0;
#define LAUNCH(lo_, hi_) do { a.ph_lo = (lo_); a.ph_hi = (hi_); a.li = li++; hipLaunchKernelGGL(mega, dim3(grid), dim3(NWAVES * 64), LDS_BYTES, stream, a); } while (0)
#if 0
#else
    a.flags = 3;
    LAUNCH(0, N_PHASES);
#endif
}
```

```cpp
#include <hip/hip_runtime.h>
#include <cstdio>
#include <cstdint>

typedef unsigned short bf16_t;
#ifndef PROBE_DUP
#define PROBE_DUP 0
#endif
#ifndef PROBE_SPIN
#define PROBE_SPIN 0
#endif
#define PROBE_TAGSEL 0

constexpr int D = 1024, BATCH = 4, SEQ = 4096, DEPTH = 4, M = BATCH * SEQ;
constexpr int RH = 4, RDK = 128, FH = 8, FD = 64, DFF = 2816, IN_COLS = 5640;
constexpr int NIN = 5888;
constexpr float EPS = 1e-6f;
constexpr int C_RQ = 0, C_RK = 512, C_RV = 1024, C_RG = 1536, C_FQ = 2048, C_FK = 2560, C_FV = 3072, C_FF = 3584, C_GR = 3592, C_GF = 4616;
constexpr float FOX_C2 = 0.125f * 1.4426950408889634f;
constexpr float RET_KSCALE = 0.08838834764831845f;

constexpr size_t MiB = 1u << 20;
constexpr size_t WS_CTL = 0, CTL_BYTES = 1 * MiB;
constexpr size_t WS_PART = 1 * MiB;
constexpr size_t WS_COS = 2 * MiB, WS_SIN = 3 * MiB;
constexpr size_t WS_LFT = 4 * MiB;
constexpr size_t WS_CUM = 4 * MiB + 512 * 1024;
constexpr size_t WS_XB = 8 * MiB;
constexpr size_t WS_QR = 40 * MiB, WS_KR = 56 * MiB, WS_VR = 72 * MiB, WS_GR = 88 * MiB, WS_FQ = 104 * MiB, WS_FK = 120 * MiB, WS_FV = 136 * MiB;
constexpr size_t WS_GATER = 152 * MiB, WS_GATEF = 184 * MiB;
constexpr size_t WS_H = 40 * MiB;
constexpr size_t WS_MERGED = 56 * MiB;
constexpr size_t WS_T = 120 * MiB;
constexpr size_t WS_W = 216 * MiB;
constexpr size_t WO_1IN = 0, WO_1OUT = 11 * MiB, WO_IN = WO_1OUT + 5632 * 1024, WO_OR = WO_IN + (size_t)NIN * 2048, WO_OF = WO_OR + MiB, WO_OUT = WO_OF + MiB,
                 WO_2IN = WO_OUT + 2 * MiB, WO_2OUT = WO_2IN + 11 * MiB, W_LAYER = WO_2OUT + 5632 * 1024;
constexpr size_t WS_END = WS_W + DEPTH * W_LAYER;
static_assert(W_LAYER == 48 * MiB + 512 * 1024, "weights per layer");

constexpr int CW_GRP = 65536;
constexpr int CW_BAR = 4096;

#define GAS __attribute__((address_space(1)))
#define LAS __attribute__((address_space(3)))
__device__ __forceinline__ float bf2f(bf16_t v) { return __uint_as_float((unsigned)v << 16); }
__device__ __forceinline__ bf16_t f2bf(float f) { unsigned u = __float_as_uint(f); return (bf16_t)((u + 0x7fffu + ((u >> 16) & 1u)) >> 16); }
__device__ __forceinline__ unsigned pk2(float lo, float hi) { return (unsigned)f2bf(lo) | ((unsigned)f2bf(hi) << 16); }
__device__ __forceinline__ float silu_f(float v) { return v / (1.f + __expf(-v)); }
__device__ __forceinline__ float sigmoid_f(float v) { return 1.f / (1.f + __expf(-v)); }
__device__ __forceinline__ float logsigmoid_f(float z) { return z >= 0.f ? -log1pf(expf(-z)) : z - log1pf(expf(z)); }
__device__ __forceinline__ float wave_sum(float v) {
#pragma unroll
    for (int o = 1; o < 64; o <<= 1) v += __shfl_xor(v, o);
    return v;
}
namespace pg8 {
#define PG8_LAS __attribute__((address_space(3)))
typedef unsigned short bf16_t;
typedef short bf16x8 __attribute__((ext_vector_type(8)));
typedef float f32x4 __attribute__((ext_vector_type(4)));
typedef unsigned u32x4 __attribute__((ext_vector_type(4)));
constexpr int BM = 256, BK = 64, HALF = 128, HTB = HALF * BK * 2  , STAGE_BYTES = 8 * HTB, NXCD = 8, WGM = 8;

__host__ __device__ __forceinline__ int lds_byte(int r, int c) { const int st = (r >> 4) * 2 + (c >> 5), rr = r & 15, cc = c & 31, ob = rr * 64 + cc * 2; return st * 1024 + (ob ^ (((ob >> 9) & 1) << 5)); }
__host__ __device__ __forceinline__ void stage_rc(int b, int& R, int& C) { const int st = b / 1024, sb = b % 1024, swz = sb ^ (((sb >> 9) & 1) << 5); R = (st >> 1) * 16 + swz / 64; C = (st & 1) * 32 + (swz % 64) / 2; }
__host__ __device__ __forceinline__ int perm32(int rho) { const int n = rho >> 4, i = rho & 15; return 8 * (i >> 2) + 4 * n + (i & 3); }

struct Unit { int pm, pn; };
struct Gemm { const bf16_t* A; const bf16_t* Bt; int M, N, K; };

struct StaticOrder {
    int nM, nN, nwg, G, c;
    __device__ void init(int M, int N, int G_, int c_) {
        asm volatile("" : "+s"(c_), "+s"(G_));
        nM = M / BM; nN = N / BM; nwg = nM * nN; G = G_; c = c_; }
    __host__ __device__ bool next(int i, Unit& u) const {
        const long L = (long)i * G + c; if (L >= nwg) return false;
        int wgid = (int)L; { const int q = nwg / NXCD, r = nwg % NXCD, xcd = wgid % NXCD, off = wgid / NXCD; wgid = (xcd < r ? xcd * (q + 1) : r * (q + 1) + (xcd - r) * q) + off; }
        const int nig = WGM * nN, gid = wgid / nig, fm = gid * WGM, gsz = (nM - fm) < WGM ? (nM - fm) : WGM;
        u.pm = fm + ((wgid % nig) % gsz); u.pn = (wgid % nig) / gsz; return true;
    }
    __device__ __forceinline__ void a_ready(const Unit&) const {}
    __device__ __forceinline__ void done(const Unit&) const {}
};
template <class Epi, class Sched, bool ALIGN_EPI = false, bool SP2 = false>
__device__ __forceinline__ void gemm_phase(PG8_LAS unsigned char* lds, const Gemm g, const Sched& S, const Epi& E) {
    int tid_ = threadIdx.x; asm volatile("" : "+v"(tid_));
    const int tid = tid_, wid = __builtin_amdgcn_readfirstlane(tid >> 6), lane = tid & 63, wr = wid >> 2, wc = wid & 3, fr = lane & 15, fq = lane >> 4;
    const int K = g.K, nt = K / BK;
    unsigned voffA[2], voffB[2];
#pragma unroll
    for (int i = 0; i < 2; ++i) { int R, C; stage_rc(tid * 16 + i * 8192, R, C); const int Rb = Epi::PERM ? ((R & ~31) + perm32(R & 31)) : R;
        voffA[i] = (unsigned)(R * K + C) * 2u; voffB[i] = (unsigned)(Rb * K + C) * 2u; }
    const size_t kstep = (size_t)(BK * 2);
    const size_t hstep = (size_t)HALF * K * 2;
    const size_t tstep = 2 * hstep;
    const unsigned ldsw = (unsigned)wid * 1024u;
    const int aoff = lds_byte(wr * 64 + fr, fq * 8), boff = lds_byte(wc * 32 + fr, fq * 8);
#define PG8_SA(b, h) (((b) * 2 + (h)) * HTB)
#define PG8_SB(b, h) ((4 + (b) * 2 + (h)) * HTB)
#define PG8_STAGE(bufoff, gbase, voff) do { _Pragma("unroll") for (int _i = 0; _i < 2; ++_i) \
        __builtin_amdgcn_global_load_lds((const unsigned*)((const char*)(gbase) + (voff)[_i]), (PG8_LAS unsigned*)(lds + (bufoff) + ldsw + _i * 8192), 16, 0, 0); } while (0)
#define PG8_LDA(dst, b, h) do { _Pragma("unroll") for (int m = 0; m < 4; ++m) _Pragma("unroll") for (int k = 0; k < 2; ++k) dst[m][k] = *(const PG8_LAS bf16x8*)(lds + PG8_SA(b, h) + aoff + m * 2048 + k * 1024); } while (0)
#define PG8_LDB(dst, b, h) do { _Pragma("unroll") for (int n = 0; n < 2; ++n) _Pragma("unroll") for (int k = 0; k < 2; ++k) dst[n][k] = *(const PG8_LAS bf16x8*)(lds + PG8_SB(b, h) + boff + n * 2048 + k * 1024); } while (0)
#define PG8_MMA(ai, bj, At, Bt) do { __builtin_amdgcn_s_setprio(1); _Pragma("unroll") for (int m = 0; m < 4; ++m) _Pragma("unroll") for (int n = 0; n < 2; ++n) _Pragma("unroll") for (int k = 0; k < 2; ++k) \
        acc[ai][bj][m][n] = __builtin_amdgcn_mfma_f32_16x16x32_bf16(Bt[n][k], At[m][k], acc[ai][bj][m][n], 0, 0, 0); __builtin_amdgcn_s_setprio(0); } while (0)
#define PG8_WAIT_V(n) asm volatile("s_waitcnt vmcnt(" #n ")" ::: "memory")
#define PG8_WAIT_L(n) asm volatile("s_waitcnt lgkmcnt(" #n ")" ::: "memory")
#define PG8_BAR __builtin_amdgcn_s_barrier()
#define PG8_SCHED __builtin_amdgcn_sched_barrier(0)
    Unit cur, nxt; int ui = 0;
    if (!S.next(0, cur)) return;
    f32x4 acc[2][2][4][2];
    if constexpr (Epi::INIT_ACC) E.init(acc, cur, wr, wc, fr, fq);
    else {
#pragma unroll
    for (int a = 0; a < 2; ++a)
#pragma unroll
        for (int b = 0; b < 2; ++b)
#pragma unroll
            for (int m = 0; m < 4; ++m)
#pragma unroll
                for (int n = 0; n < 2; ++n) acc[a][b][m][n] = (f32x4){0.f, 0.f, 0.f, 0.f};
    }
    bf16x8 At[4][2], B0[2][2], B1[2][2];
    const char* cA = (const char*)g.A + (size_t)cur.pm * tstep; const char* cB = (const char*)g.Bt + (size_t)cur.pn * tstep;
    S.a_ready(cur);
    if constexpr (SP2) {
        PG8_STAGE(PG8_SB(0, 0), cB, voffB); PG8_STAGE(PG8_SB(0, 1), cB + hstep, voffB); PG8_STAGE(PG8_SA(0, 0), cA, voffA); PG8_STAGE(PG8_SA(0, 1), cA + hstep, voffA);
        PG8_STAGE(PG8_SB(1, 0), cB + kstep, voffB); PG8_STAGE(PG8_SA(1, 0), cA + kstep, voffA); PG8_STAGE(PG8_SB(1, 1), cB + hstep + kstep, voffB);
        if (wr == 1) PG8_BAR;
        PG8_WAIT_V(8); PG8_BAR;
        PG8_WAIT_V(6); PG8_BAR;
    } else {
        PG8_STAGE(PG8_SB(0, 0), cB, voffB); PG8_STAGE(PG8_SA(0, 0), cA, voffA); PG8_STAGE(PG8_SB(0, 1), cB + hstep, voffB); PG8_STAGE(PG8_SA(0, 1), cA + hstep, voffA);
        if (wr == 1) PG8_BAR;
        PG8_WAIT_V(4); PG8_BAR;
        PG8_STAGE(PG8_SB(1, 0), cB + kstep, voffB); PG8_STAGE(PG8_SA(1, 0), cA + kstep, voffA); PG8_STAGE(PG8_SB(1, 1), cB + hstep + kstep, voffB);
        PG8_WAIT_V(6); PG8_BAR;
    }
    for (;;) {
        const bool has_next = S.next(ui + 1, nxt);
        const char* nA = has_next ? (const char*)g.A + (size_t)nxt.pm * tstep : cA; const char* nB = has_next ? (const char*)g.Bt + (size_t)nxt.pn * tstep : cB;
#if defined(PROBE_SPIN) && (PROBE_SPIN == 4)
        unsigned pk0_ = 0; if constexpr (Epi::PROBE_TAG) pk0_ = (unsigned)__builtin_amdgcn_s_memrealtime();
#endif
        for (int t = 0; t < nt; t += 2) {
            const bool last = (t == nt - 2);
            const char* a1 = cA + (size_t)(t + 1) * kstep;
            const char* a2 = last ? nA : cA + (size_t)(t + 2) * kstep; const char* b2 = last ? nB : cB + (size_t)(t + 2) * kstep;
            const char* a3 = a2 + kstep; const char* b3 = b2 + kstep;
            if (last && has_next) S.a_ready(nxt);
            if constexpr (Epi::MIDHOOK) { if (t == nt / 2) E.mid(acc, cur, wr, wc, fr, fq); }
            if constexpr (SP2) {
            PG8_LDB(B0, 0, 0); PG8_LDB(B1, 0, 1); PG8_SCHED; PG8_LDA(At, 0, 0); PG8_STAGE(PG8_SA(1, 1), a1 + hstep, voffA);
            PG8_WAIT_V(8); PG8_WAIT_L(0); PG8_BAR; PG8_MMA(0, 0, At, B0); PG8_MMA(0, 1, At, B1); PG8_BAR; PG8_SCHED;
            PG8_LDA(At, 0, 1); PG8_STAGE(PG8_SB(0, 0), b2, voffB); PG8_STAGE(PG8_SB(0, 1), b2 + hstep, voffB); PG8_STAGE(PG8_SA(0, 0), a2, voffA);
            PG8_WAIT_V(8); PG8_WAIT_L(0); PG8_BAR; PG8_MMA(1, 0, At, B0); PG8_MMA(1, 1, At, B1); PG8_BAR; PG8_SCHED;
            PG8_LDB(B0, 1, 0); PG8_LDB(B1, 1, 1); PG8_SCHED; PG8_LDA(At, 1, 0); PG8_STAGE(PG8_SA(0, 1), a2 + hstep, voffA);
            PG8_WAIT_V(8); PG8_WAIT_L(0); PG8_BAR; PG8_MMA(0, 0, At, B0); PG8_MMA(0, 1, At, B1); PG8_BAR; PG8_SCHED;
            PG8_LDA(At, 1, 1); PG8_STAGE(PG8_SB(1, 0), b3, voffB); PG8_STAGE(PG8_SB(1, 1), b3 + hstep, voffB); PG8_STAGE(PG8_SA(1, 0), a3, voffA);
            PG8_WAIT_V(8); PG8_WAIT_L(0); PG8_BAR; PG8_MMA(1, 0, At, B0); PG8_MMA(1, 1, At, B1); PG8_BAR; PG8_SCHED;
            } else {
            PG8_LDB(B0, 0, 0); PG8_SCHED; PG8_LDA(At, 0, 0); PG8_STAGE(PG8_SA(1, 1), a1 + hstep, voffA);
            PG8_WAIT_L(8); PG8_BAR; PG8_WAIT_L(0); PG8_MMA(0, 0, At, B0); PG8_BAR; PG8_SCHED;
            PG8_LDB(B1, 0, 1); PG8_STAGE(PG8_SB(0, 0), b2, voffB);
            PG8_BAR; PG8_WAIT_L(0); PG8_MMA(0, 1, At, B1); PG8_BAR;
            PG8_LDA(At, 0, 1); PG8_STAGE(PG8_SA(0, 0), a2, voffA);
            PG8_BAR; PG8_WAIT_L(0); PG8_MMA(1, 0, At, B0); PG8_BAR; PG8_SCHED;
            PG8_STAGE(PG8_SB(0, 1), b2 + hstep, voffB);
            PG8_WAIT_V(6); PG8_BAR; PG8_MMA(1, 1, At, B1); PG8_BAR;
            PG8_LDB(B0, 1, 0); PG8_SCHED; PG8_LDA(At, 1, 0); PG8_STAGE(PG8_SA(0, 1), a2 + hstep, voffA);
            PG8_WAIT_L(8); PG8_BAR; PG8_WAIT_L(0); PG8_MMA(0, 0, At, B0); PG8_BAR; PG8_SCHED;
            PG8_LDB(B1, 1, 1); PG8_STAGE(PG8_SB(1, 0), b3, voffB);
            PG8_BAR; PG8_WAIT_L(0); PG8_MMA(0, 1, At, B1); PG8_BAR;
            PG8_LDA(At, 1, 1); PG8_STAGE(PG8_SA(1, 0), a3, voffA);
            PG8_BAR; PG8_WAIT_L(0); PG8_MMA(1, 0, At, B0); PG8_BAR; PG8_SCHED;
            PG8_STAGE(PG8_SB(1, 1), b3 + hstep, voffB);
            PG8_WAIT_V(6); PG8_BAR; PG8_MMA(1, 1, At, B1); PG8_BAR;
            }
        }
#if defined(PROBE_SPIN) && (PROBE_SPIN == 4)
        if constexpr (Epi::PROBE_TAG) { if (threadIdx.x == 0) { volatile PG8_LAS unsigned* mi_ = (volatile PG8_LAS unsigned*)(lds + 131072 + 320); mi_[16] = mi_[16] + ((unsigned)__builtin_amdgcn_s_memrealtime() - pk0_); } }
#endif
        if constexpr (ALIGN_EPI) { if (wr == 0) PG8_BAR; }
#if defined(PROBE_SPIN) && (PROBE_SPIN == 3)
        unsigned pe0_ = 0; if constexpr (Epi::PROBE_TAG) pe0_ = (unsigned)__builtin_amdgcn_s_memrealtime();
#endif
        if constexpr (!Epi::AFTER_DRAIN) { E(acc, cur, wr, wc, fr, fq);
#if defined(PROBE_SPIN) && (PROBE_SPIN == 3)
            if constexpr (Epi::PROBE_TAG) { asm volatile("s_waitcnt vmcnt(0)" ::: "memory"); if (threadIdx.x == 0) { volatile PG8_LAS unsigned* mi_ = (volatile PG8_LAS unsigned*)(lds + 131072 + 320); mi_[16] = mi_[16] + ((unsigned)__builtin_amdgcn_s_memrealtime() - pe0_); } }
#endif
#if defined(PROBE_DUP) && (PROBE_DUP & 512)
            if constexpr (Epi::IDEMPOTENT) { asm volatile("" ::: "memory"); E(acc, cur, wr, wc, fr, fq); }
#endif
            S.done(cur); }
        if (!has_next) break;
        if constexpr (Epi::INIT_ACC) E.init(acc, nxt, wr, wc, fr, fq);
        else {
#pragma unroll
        for (int a = 0; a < 2; ++a)
#pragma unroll
            for (int b = 0; b < 2; ++b)
#pragma unroll
                for (int m = 0; m < 4; ++m)
#pragma unroll
                    for (int n = 0; n < 2; ++n) acc[a][b][m][n] = (f32x4){0.f, 0.f, 0.f, 0.f};
        }
        cur = nxt; cA = nA; cB = nB; ++ui;
        if constexpr (ALIGN_EPI) { if (wr == 1) PG8_BAR; }
    }
    PG8_WAIT_V(0);
    if constexpr (!ALIGN_EPI) { if (wr == 0) PG8_BAR; }
    PG8_BAR;
    if constexpr (Epi::AFTER_DRAIN) { E.fused(acc, cur, wr, wc, fr, fq, lds, wid, lane); S.done(cur); }
#undef PG8_SA
#undef PG8_SB
#undef PG8_STAGE
#undef PG8_LDA
#undef PG8_LDB
#undef PG8_MMA
#undef PG8_WAIT_V
#undef PG8_WAIT_L
#undef PG8_BAR
#undef PG8_SCHED
}
}
namespace pg8 {
__device__ __forceinline__ unsigned cvt_pk_bf16(float lo, float hi) { unsigned r; asm volatile("v_cvt_pk_bf16_f32 %0, %1, %2" : "=v"(r) : "v"(lo), "v"(hi)); return r; }
__device__ __forceinline__ u32x4 pack8(const f32x4 a, const f32x4 b) { u32x4 w; w.x = cvt_pk_bf16(a[0], a[1]); w.y = cvt_pk_bf16(a[2], a[3]); w.z = cvt_pk_bf16(b[0], b[1]); w.w = cvt_pk_bf16(b[2], b[3]); return w; }
__device__ __forceinline__ f32x4 unpack_lo(const u32x4 w) { return (f32x4){__uint_as_float(w.x << 16), __uint_as_float(w.x & 0xffff0000u), __uint_as_float(w.y << 16), __uint_as_float(w.y & 0xffff0000u)}; }
__device__ __forceinline__ f32x4 unpack_hi(const u32x4 w) { return (f32x4){__uint_as_float(w.z << 16), __uint_as_float(w.z & 0xffff0000u), __uint_as_float(w.w << 16), __uint_as_float(w.w & 0xffff0000u)}; }
__device__ __forceinline__ float fast_sigmoid(float v) { return __builtin_amdgcn_rcpf(1.f + __builtin_amdgcn_exp2f(-1.4426950408889634f * v)); }
__device__ __forceinline__ float fast_logsigmoid(float z) { return fminf(z, 0.f) - 0.6931471805599453f * __builtin_amdgcn_logf(1.f + __builtin_amdgcn_exp2f(-1.4426950408889634f * fabsf(z))); }
__device__ __forceinline__ f32x4 sigmoid4(const f32x4 v) { return (f32x4){fast_sigmoid(v[0]), fast_sigmoid(v[1]), fast_sigmoid(v[2]), fast_sigmoid(v[3])}; }
__device__ __forceinline__ f32x4 silu4(const f32x4 v) { return v * sigmoid4(v); }
__device__ __forceinline__ void store_wt(void* p, const u32x4 v) { asm volatile("global_store_dwordx4 %0, %1, off sc1\n\ts_nop 1" :: "v"(p), "v"(v) : "memory"); }
__device__ __forceinline__ float rstd_row(const float* part, int row, int fq) {
    const f32x4 p = *(const f32x4*)(part + (size_t)row * 16 + 4 * fq);
    float s = (p[0] + p[1]) + (p[2] + p[3]);
    s += __shfl_xor(s, 16); s += __shfl_xor(s, 32);
    return rsqrtf(s * (1.f / 1024.f) + 1e-6f);
}

__device__ __forceinline__ void rstd_rows8(const float* part, int row0, int fq, float (&r)[2][4]) {
    f32x4 p[2][4];
#pragma unroll
    for (int ai = 0; ai < 2; ++ai)
#pragma unroll
        for (int m = 0; m < 4; ++m) p[ai][m] = *(const f32x4*)(part + (size_t)(row0 + ai * HALF + m * 16) * 16 + 4 * fq);
#pragma unroll
    for (int ai = 0; ai < 2; ++ai)
#pragma unroll
        for (int m = 0; m < 4; ++m) { float s = (p[ai][m][0] + p[ai][m][1]) + (p[ai][m][2] + p[ai][m][3]); s += __shfl_xor(s, 16); s += __shfl_xor(s, 32); r[ai][m] = rsqrtf(s * (1.f / 1024.f) + 1e-6f); }
}

struct RstdTab { const float* part; const PG8_LAS float* tab; int pm0; };
__device__ __forceinline__ void rstd_fill(const float* part, int pm, PG8_LAS float* tab, int tid) {
    if (__builtin_amdgcn_readfirstlane(tid >> 6) < 4) {     const f32x4* p = (const f32x4*)(part + (size_t)(pm * BM + tid) * 16); const f32x4 a = p[0], b = p[1], c = p[2], d = p[3];
        const float s = ((a[0] + a[1]) + (a[2] + a[3])) + ((b[0] + b[1]) + (b[2] + b[3])) + ((c[0] + c[1]) + (c[2] + c[3])) + ((d[0] + d[1]) + (d[2] + d[3]));
        tab[tid] = rsqrtf(s * (1.f / 1024.f) + 1e-6f); }
    __syncthreads();
}
__device__ __forceinline__ void rstd_get8(const RstdTab& T, const Unit& u, int wr, int fr, int fq, float (&r)[2][4]) {
    if (u.pm == T.pm0) {
#pragma unroll
        for (int ai = 0; ai < 2; ++ai)
#pragma unroll
            for (int m = 0; m < 4; ++m) r[ai][m] = T.tab[wr * 64 + fr + ai * HALF + m * 16];
    } else rstd_rows8(T.part, u.pm * BM + wr * 64 + fr, fq, r);
}

struct EpiSwiglu {
    static constexpr bool INIT_ACC = false, PERM = true, AFTER_DRAIN = false, MIDHOOK = false, IDEMPOTENT = true, PROBE_TAG = (PROBE_TAGSEL == 0);
    bf16_t* H; RstdTab rt;
    __device__ __forceinline__ void operator()(const f32x4 (&acc)[2][2][4][2], const Unit& u, int wr, int wc, int fr, int fq) const {
        const int row0 = u.pm * BM + wr * 64 + fr, hcol = u.pn * 128 + wc * 32 + 8 * fq;
        float rr[2][4]; rstd_get8(rt, u, wr, fr, fq, rr);
#pragma unroll
        for (int ai = 0; ai < 2; ++ai)
#pragma unroll
            for (int m = 0; m < 4; ++m) {
                const int row = row0 + ai * HALF + m * 16; const float r = rr[ai][m], nr = -1.4426950408889634f * r, r2 = r * r;
                f32x4 h[2];
#pragma unroll
                for (int n = 0; n < 2; ++n) { const f32x4 a = acc[ai][0][m][n], t = a * nr;
                    const f32x4 d = (f32x4){__builtin_amdgcn_exp2f(t[0]), __builtin_amdgcn_exp2f(t[1]), __builtin_amdgcn_exp2f(t[2]), __builtin_amdgcn_exp2f(t[3])} + 1.f;
                    const f32x4 sg = (f32x4){__builtin_amdgcn_rcpf(d[0]), __builtin_amdgcn_rcpf(d[1]), __builtin_amdgcn_rcpf(d[2]), __builtin_amdgcn_rcpf(d[3])};
                    h[n] = ((a * acc[ai][1][m][n]) * sg) * r2; }
                store_wt(H + (size_t)row * 2816 + hcol, pack8(h[0], h[1]));
            }
    }
};
struct EpiResid {
    static constexpr bool INIT_ACC = true, PROBE_TAG = (PROBE_TAGSEL == 2), PERM = true, AFTER_DRAIN = false, MIDHOOK = false, IDEMPOTENT = false;
    bf16_t* xb; float* part; float alpha, inv_alpha;
    __device__ __forceinline__ void init(f32x4 (&acc)[2][2][4][2], const Unit& u, int wr, int wc, int fr, int fq) const {
        const int row0 = u.pm * BM + wr * 64 + fr, col0 = u.pn * BM + wc * 32 + 8 * fq;
#pragma unroll
        for (int ai = 0; ai < 2; ++ai)
#pragma unroll
            for (int m = 0; m < 4; ++m)
#pragma unroll
                for (int bj = 0; bj < 2; ++bj) { const u32x4 w = *(const u32x4*)(xb + (size_t)(row0 + ai * HALF + m * 16) * 1024 + col0 + bj * HALF);
                    acc[ai][bj][m][0] = unpack_lo(w) * inv_alpha; acc[ai][bj][m][1] = unpack_hi(w) * inv_alpha; }
    }
    __device__ __forceinline__ void operator()(const f32x4 (&acc)[2][2][4][2], const Unit& u, int wr, int wc, int fr, int fq) const {
        const int row0 = u.pm * BM + wr * 64 + fr, col0 = u.pn * BM + wc * 32 + 8 * fq;
#pragma unroll
        for (int ai = 0; ai < 2; ++ai)
#pragma unroll
            for (int m = 0; m < 4; ++m) {
                const int row = row0 + ai * HALF + m * 16; float ss = 0.f;
#pragma unroll
                for (int bj = 0; bj < 2; ++bj) {
                    const u32x4 w = pack8(acc[ai][bj][m][0] * alpha, acc[ai][bj][m][1] * alpha);
                    *(u32x4*)(xb + (size_t)row * 1024 + col0 + bj * HALF) = w;
                    const f32x4 v0 = unpack_lo(w), v1 = unpack_hi(w);
                    ss += (v0[0] * v0[0] + v0[1] * v0[1]) + (v0[2] * v0[2] + v0[3] * v0[3]) + (v1[0] * v1[0] + v1[1] * v1[1]) + (v1[2] * v1[2] + v1[3] * v1[3]);
                }
                ss += __shfl_xor(ss, 16); ss += __shfl_xor(ss, 32);
                if (fq == 0) part[(size_t)row * 16 + u.pn * 4 + wc] = ss;
            }
    }
};
struct EpiInproj {
    static constexpr bool INIT_ACC = false, PROBE_TAG = (PROBE_TAGSEL == 1), PERM = true, AFTER_DRAIN = false, MIDHOOK = false, IDEMPOTENT = true;
    RstdTab rt; const float* cs; const float* sn; const float* bforget; unsigned char* ws; float* lft;
    __device__ __forceinline__ void operator()(const f32x4 (&acc)[2][2][4][2], const Unit& u, int wr, int wc, int fr, int fq) const {
        const int row0 = u.pm * BM + wr * 64 + fr, pn = u.pn;
        float rr[2][4]; rstd_get8(rt, u, wr, fr, fq, rr);
        if (pn < 4) {
            bf16_t* dst = (bf16_t*)(ws + (pn < 2 ? WS_QR : WS_KR)); const float scale = pn < 2 ? 1.f : RET_KSCALE;
            const int head = 2 * (pn & 1) + (wc >> 1), i0 = 32 * (wc & 1) + 8 * fq;
            f32x4 cv[3][2], sv[3][2];
#define ROPE_LD(j, slot) do { const int s = (row0 + ((j) >> 2) * HALF + ((j) & 3) * 16) & (SEQ - 1); \
                cv[slot][0] = *(const f32x4*)(cs + s * 64 + i0); cv[slot][1] = *(const f32x4*)(cs + s * 64 + i0 + 4); sv[slot][0] = *(const f32x4*)(sn + s * 64 + i0); sv[slot][1] = *(const f32x4*)(sn + s * 64 + i0 + 4); } while (0)
            ROPE_LD(0, 0); ROPE_LD(1, 1);
#pragma unroll
            for (int j = 0; j < 8; ++j) { const int ai = j >> 2, m = j & 3, cb = j % 3;
                if (j < 6) ROPE_LD(j + 2, (j + 2) % 3);
                const int row = row0 + ai * HALF + m * 16; const float r = rr[ai][m] * scale;
                const f32x4 a0 = acc[ai][0][m][0] * r, a1 = acc[ai][0][m][1] * r, b0 = acc[ai][1][m][0] * r, b1 = acc[ai][1][m][1] * r;
                bf16_t* o = dst + (size_t)row * 512 + head * 128 + i0;
                *(u32x4*)o = pack8(a0 * cv[cb][0] - b0 * sv[cb][0], a1 * cv[cb][1] - b1 * sv[cb][1]);
                *(u32x4*)(o + 64) = pack8(a0 * sv[cb][0] + b0 * cv[cb][0], a1 * sv[cb][1] + b1 * cv[cb][1]);
            }
#undef ROPE_LD
        } else if (pn < 14) {
            const int grp = (pn - 4) >> 1;
            const size_t off = grp == 0 ? WS_VR : grp == 1 ? WS_GR : grp == 2 ? WS_FQ : grp == 3 ? WS_FK : WS_FV;
            const float scale = grp == 2 ? FOX_C2 : 1.f;
            bf16_t* dst = (bf16_t*)(ws + off) + 256 * (pn & 1) + wc * 32 + 8 * fq;
#pragma unroll
            for (int ai = 0; ai < 2; ++ai)
#pragma unroll
                for (int m = 0; m < 4; ++m) {
                    const int row = row0 + ai * HALF + m * 16; const float r = rr[ai][m] * scale;
#pragma unroll
                    for (int bj = 0; bj < 2; ++bj) {
                        f32x4 v0 = acc[ai][bj][m][0] * r, v1 = acc[ai][bj][m][1] * r;
                        if (grp == 1) { v0 = silu4(v0); v1 = silu4(v1); }
                        *(u32x4*)(dst + (size_t)row * 512 + bj * HALF) = pack8(v0, v1);
                    }
                }
        } else if (pn < 22) {
            const int colg = 128 * (pn - 14) + wc * 32 + 8 * fq;
#pragma unroll
            for (int ai = 0; ai < 2; ++ai)
#pragma unroll
                for (int m = 0; m < 4; ++m) {
                    const int row = row0 + ai * HALF + m * 16; const float nr = -1.4426950408889634f * rr[ai][m];
                    f32x4 rt[2], sf[2];
#pragma unroll
                    for (int n = 0; n < 2; ++n) { const f32x4 tr = acc[ai][0][m][n] * nr, tf = acc[ai][1][m][n] * nr;
                        const f32x4 dr = (f32x4){__builtin_amdgcn_exp2f(tr[0]), __builtin_amdgcn_exp2f(tr[1]), __builtin_amdgcn_exp2f(tr[2]), __builtin_amdgcn_exp2f(tr[3])} + 1.f;
                        const f32x4 df = (f32x4){__builtin_amdgcn_exp2f(tf[0]), __builtin_amdgcn_exp2f(tf[1]), __builtin_amdgcn_exp2f(tf[2]), __builtin_amdgcn_exp2f(tf[3])} + 1.f;
                        sf[n] = (f32x4){__builtin_amdgcn_rcpf(df[0]), __builtin_amdgcn_rcpf(df[1]), __builtin_amdgcn_rcpf(df[2]), __builtin_amdgcn_rcpf(df[3])};
                        rt[n] = df * (f32x4){__builtin_amdgcn_rcpf(dr[0]), __builtin_amdgcn_rcpf(dr[1]), __builtin_amdgcn_rcpf(dr[2]), __builtin_amdgcn_rcpf(dr[3])}; }
                    *(u32x4*)((bf16_t*)(ws + WS_GATER) + (size_t)row * 1024 + colg) = pack8(rt[0], rt[1]);
                    *(u32x4*)((bf16_t*)(ws + WS_GATEF) + (size_t)row * 1024 + colg) = pack8(sf[0], sf[1]);
                }
        } else if (wc == 0) {
            float bfv[8];
#pragma unroll
            for (int hd = 0; hd < 8; ++hd) bfv[hd] = __int_as_float(__builtin_amdgcn_readfirstlane(__float_as_int(bforget[hd])));
            if (fq == 0) {
#pragma unroll
                for (int ai = 0; ai < 2; ++ai)
#pragma unroll
                    for (int m = 0; m < 4; ++m) {
                        const int row = row0 + ai * HALF + m * 16; const float r = rr[ai][m];
                        const int b = row >> 12, s = row & (SEQ - 1);
                        float* dst = lft + (size_t)(b * FH) * SEQ + s;
#pragma unroll
                        for (int n = 0; n < 2; ++n)
#pragma unroll
                            for (int e = 0; e < 4; ++e) { const int hd = 4 * n + e; dst[(size_t)hd * SEQ] = fast_logsigmoid(acc[ai][0][m][n][e] * r + bfv[hd]); }
                    }
            }
        }
    }
};
struct EpiGated {
    static constexpr bool INIT_ACC = false, PROBE_TAG = (PROBE_TAGSEL == 3), PERM = true, AFTER_DRAIN = false, MIDHOOK = true, IDEMPOTENT = true;
    const bf16_t* ratio; const bf16_t* sigf; bf16_t* out;
    __device__ __forceinline__ void mid(f32x4 (&acc)[2][2][4][2], const Unit& u, int wr, int wc, int fr, int fq) const {
        asm volatile("" : "+v"(fr), "+v"(fq));
        const int row0 = u.pm * BM + wr * 64 + fr, col0 = u.pn * BM + wc * 32 + 8 * fq;
        u32x4 g[2][4][2];
#pragma unroll
        for (int ai = 0; ai < 2; ++ai)
#pragma unroll
            for (int m = 0; m < 4; ++m)
#pragma unroll
                for (int bj = 0; bj < 2; ++bj) g[ai][m][bj] = *(const u32x4*)(ratio + (size_t)(row0 + ai * HALF + m * 16) * 1024 + col0 + bj * HALF);
#pragma unroll
        for (int ai = 0; ai < 2; ++ai)
#pragma unroll
            for (int m = 0; m < 4; ++m)
#pragma unroll
                for (int bj = 0; bj < 2; ++bj) { acc[ai][bj][m][0] *= unpack_lo(g[ai][m][bj]); acc[ai][bj][m][1] *= unpack_hi(g[ai][m][bj]); }
    }
    __device__ __forceinline__ void operator()(const f32x4 (&acc)[2][2][4][2], const Unit& u, int wr, int wc, int fr, int fq) const {
        const int row0 = u.pm * BM + wr * 64 + fr, col0 = u.pn * BM + wc * 32 + 8 * fq;
        u32x4 g[2][4][2];
#pragma unroll
        for (int ai = 0; ai < 2; ++ai)
#pragma unroll
            for (int m = 0; m < 4; ++m)
#pragma unroll
                for (int bj = 0; bj < 2; ++bj) g[ai][m][bj] = *(const u32x4*)(sigf + (size_t)(row0 + ai * HALF + m * 16) * 1024 + col0 + bj * HALF);
#pragma unroll
        for (int ai = 0; ai < 2; ++ai)
#pragma unroll
            for (int m = 0; m < 4; ++m)
#pragma unroll
                for (int bj = 0; bj < 2; ++bj)
                    store_wt(out + (size_t)(row0 + ai * HALF + m * 16) * 1024 + col0 + bj * HALF, pack8(unpack_lo(g[ai][m][bj]) * acc[ai][bj][m][0], unpack_hi(g[ai][m][bj]) * acc[ai][bj][m][1]));
    }
};
}
#include <hip/hip_bf16.h>
namespace fox {
using bf16=__hip_bfloat16;
using bf16x8=__attribute__((ext_vector_type(8)))short;
using s16x4=__attribute__((ext_vector_type(4)))short;
using f32x16=__attribute__((ext_vector_type(16)))float;
using u32x4=__attribute__((ext_vector_type(4)))unsigned;
constexpr int BATCH=4,NHEAD=8,SEQ=4096,D=64,DM=NHEAD*D;
constexpr int NW=8,QBLK=32,QB=QBLK*NW,KVBLK=64,NQB=SEQ/QB;
constexpr int ATTN_PITCH=DM, ATTN_UNIT_ROWS=QB, OPITCH=1024;
__device__ __forceinline__ int crow(int r,int hi){return (r&3)+8*(r>>2)+4*hi;}
#define SBAR() __builtin_amdgcn_sched_barrier(0)
__device__ __forceinline__ void cmask(f32x16&p0,f32x16&p1,int jb,int qrel,int hi){
  const float NEG=-INFINITY; int kb=64*jb+4*hi;
  #pragma unroll
  for(int r=0;r<16;++r){int kv=kb+(r&3)+8*(r>>2); if(kv>qrel)p0[r]=NEG; if(kv+32>qrel)p1[r]=NEG;}
}

constexpr int NSLOT=3, SLOTB=8192;
constexpr int LDS_K=0, LDS_V=NSLOT*SLOTB, LDS_WS=2*NSLOT*SLOTB, LDS_OST=LDS_WS+NW*64*4, LDS_CUM=LDS_OST+NW*4096, LDS_BYTES=LDS_CUM+(SEQ+8)*8;
constexpr float C2=0.125f*1.4426950408889634f;
__device__ __forceinline__ void glds16(const void*gsrc,unsigned lds_dst){unsigned keep;
  asm volatile("s_mov_b32 %0, m0\n\ts_mov_b32 m0, %2\n\ts_nop 0\n\tglobal_load_lds_dwordx4 %1, off\n\ts_mov_b32 m0, %0":"=&s"(keep):"v"(gsrc),"s"(lds_dst):"memory");}
__device__ __forceinline__ float max3f(float a,float b,float c){float r;asm("v_max3_f32 %0, %1, %2, %3":"=v"(r):"v"(a),"v"(b),"v"(c));return r;}
__device__ __forceinline__ float max2f(float a,float b){float r;asm("v_max_f32_e32 %0, %1, %2":"=v"(r):"v"(a),"v"(b));return r;}
__device__ __forceinline__ float fadd_s(float a,float b){float r;asm("v_add_f32_e32 %0, %1, %2":"=v"(r):"v"(a),"v"(b));return r;}
__device__ __forceinline__ float fsub_s(float a,float b){float r;asm("v_sub_f32_e32 %0, %1, %2":"=v"(r):"v"(a),"v"(b));return r;}
typedef float f32x2_t __attribute__((ext_vector_type(2))); typedef __bf16 bf16x2_t __attribute__((ext_vector_type(2)));
__device__ __forceinline__ unsigned cvtpk_s(float lo,float hi){f32x2_t v={lo,hi};bf16x2_t b=__builtin_convertvector(v,bf16x2_t);return __builtin_bit_cast(unsigned,b);}
#define WAIT_BAR(N) asm volatile("s_waitcnt vmcnt(" #N ") lgkmcnt(0)\n\ts_barrier":::"memory")

__device__ __forceinline__ void qkt(f32x16&p0,f32x16&p1,const char*Kslot,const bf16x8*qr,const f32x16&i0,const f32x16&i1,int r32,int hi){
  const char*kb=Kslot+hi*1024+r32*16;
  #pragma unroll
  for(int d0=0;d0<4;++d0){
    const bf16x8 b0=*reinterpret_cast<const bf16x8*>(kb+d0*2048);
    const bf16x8 b1=*reinterpret_cast<const bf16x8*>(kb+d0*2048+512);
    if(d0==0){p0=__builtin_amdgcn_mfma_f32_32x32x16_bf16(b0,qr[0],i0,0,0,0);p1=__builtin_amdgcn_mfma_f32_32x32x16_bf16(b1,qr[0],i1,0,0,0);}
    else{p0=__builtin_amdgcn_mfma_f32_32x32x16_bf16(b0,qr[d0],p0,0,0,0);p1=__builtin_amdgcn_mfma_f32_32x32x16_bf16(b1,qr[d0],p1,0,0,0);}}
}
typedef __attribute__((address_space(3))) const char* lds_cptr;
typedef short v4i16_t __attribute__((ext_vector_type(4)));
__device__ __forceinline__ void kload8(bf16x8*kf,lds_cptr kp){
  kf[0]=*(const __attribute__((address_space(3))) bf16x8*)(kp);      kf[1]=*(const __attribute__((address_space(3))) bf16x8*)(kp+512);
  kf[2]=*(const __attribute__((address_space(3))) bf16x8*)(kp+2048); kf[3]=*(const __attribute__((address_space(3))) bf16x8*)(kp+2560);
  kf[4]=*(const __attribute__((address_space(3))) bf16x8*)(kp+4096); kf[5]=*(const __attribute__((address_space(3))) bf16x8*)(kp+4608);
  kf[6]=*(const __attribute__((address_space(3))) bf16x8*)(kp+6144); kf[7]=*(const __attribute__((address_space(3))) bf16x8*)(kp+6656);
}
__device__ __forceinline__ void kload2(bf16x8*kf,lds_cptr kp,int j){ kf[2*j]=*(const __attribute__((address_space(3))) bf16x8*)(kp+j*2048); kf[2*j+1]=*(const __attribute__((address_space(3))) bf16x8*)(kp+j*2048+512); }
__device__ __forceinline__ s16x4 vtr(lds_cptr p){ return __builtin_bit_cast(s16x4,__builtin_amdgcn_ds_read_tr16_b64_v4i16((__attribute__((address_space(3))) v4i16_t*)p)); }
__device__ __forceinline__ float rowmax(const f32x16&p0,const f32x16&p1){
  float a=max3f(p0[0],p0[1],p1[0]),b=max3f(p0[2],p0[3],p1[1]);a=max3f(a,p1[2],p1[3]);
  #pragma unroll
  for(int r=4;r<16;r+=4){a=max3f(a,p0[r],p0[r+1]);b=max3f(b,p0[r+2],p0[r+3]);a=max3f(a,p1[r],p1[r+1]);b=max3f(b,p1[r+2],p1[r+3]);}
  const float m=max2f(a,b);
  auto rr=__builtin_amdgcn_permlane32_swap(__float_as_uint(m),__float_as_uint(m),false,false);
  return max2f(__uint_as_float(rr[0]),__uint_as_float(rr[1]));
}
__device__ __forceinline__ void pv(f32x16*o,int vb,bf16x8 pa0,bf16x8 pa1,bf16x8 pa2,bf16x8 pa3){
  #pragma unroll
  for(int d0=0;d0<2;++d0){s16x4 lo[4],hi[4];
    #pragma unroll
    for(int ks=0;ks<4;++ks){
      asm volatile("ds_read_b64_tr_b16 %0,%1 offset:%c2":"=&v"(lo[ks]):"v"(vb),"i"(d0*4096+ks*1024):"memory");
      asm volatile("ds_read_b64_tr_b16 %0,%1 offset:%c2":"=&v"(hi[ks]):"v"(vb),"i"(d0*4096+ks*1024+512):"memory");}
    asm volatile("s_waitcnt lgkmcnt(0)":::"memory");SBAR();
    #define PK(k) (bf16x8){lo[k][0],lo[k][1],lo[k][2],lo[k][3],hi[k][0],hi[k][1],hi[k][2],hi[k][3]}
    o[d0]=__builtin_amdgcn_mfma_f32_32x32x16_bf16(pa0,PK(0),o[d0],0,0,0);
    o[d0]=__builtin_amdgcn_mfma_f32_32x32x16_bf16(pa1,PK(1),o[d0],0,0,0);
    o[d0]=__builtin_amdgcn_mfma_f32_32x32x16_bf16(pa2,PK(2),o[d0],0,0,0);
    o[d0]=__builtin_amdgcn_mfma_f32_32x32x16_bf16(pa3,PK(3),o[d0],0,0,0);
    #undef PK
  }
}

#ifndef ATTN_STORE16
#define ATTN_STORE16(p,v) (*(u32x4*)(p)=(v))
#endif
template<int THRL> __device__ __forceinline__ void attn_unit(int b,int h,int qb,const bf16*Q,const bf16*__restrict__ K,const bf16*__restrict__ V,bf16*O,char*shm){
  int tid_=threadIdx.x; asm volatile("":"+v"(tid_)); const int tid=tid_,lane=tid&63,r32=lane&31,hi=lane>>5; const int wid=__builtin_amdgcn_readfirstlane(tid>>6);
  const long rowbase=(long)b*SEQ; const int q0=qb*QB;
  const bf16*Qw=Q+(rowbase+q0+wid*QBLK)*DM+h*D;
  const bf16*Kh=K+rowbase*DM+h*D,*Vh=V+rowbase*DM+h*D;
  const lds_cptr shm3=(lds_cptr)shm;
  const unsigned lds0=(unsigned)(uintptr_t)shm;
  float*wsf=(float*)(shm+LDS_WS)+wid*64;
  const bf16*ksrc=Kh+(long)lane*DM+wid*8;
  const bf16*vsrc=Vh+(long)(16*(wid&3)+(lane>>2))*DM+(wid>>2)*32+(lane&3)*8;
  const unsigned kdst=lds0+LDS_K+wid*1024, vdst=lds0+LDS_V+wid*1024;
  #define TILE(t) (((t)<NT-4)?(NT-5-(t)):(t))
  #define DMA_K(t,slot) glds16(ksrc+(long)TILE(t)*KVBLK*DM,(unsigned)__builtin_amdgcn_readfirstlane(kdst+(slot)))
  #define DMA_V(t,slot) glds16(vsrc+(long)TILE(t)*KVBLK*DM,(unsigned)__builtin_amdgcn_readfirstlane(vdst+(slot)))
  const int vb0=(int)(lds0+LDS_V)+((lane>>4)&1)*32+(lane&3)*8+(4*hi+((lane&15)>>2))*64;
  const char*Kbase=shm+LDS_K; bf16x8 kf[8];
  const lds_cptr kp0=shm3+LDS_K+hi*1024+r32*16; const lds_cptr vp0=shm3+LDS_V+((lane>>4)&1)*32+(lane&3)*8+(4*hi+((lane&15)>>2))*64;
  const int NT=(q0+QB)/KVBLK;
  DMA_K(0,0);DMA_V(0,0);DMA_K(1,SLOTB);
  bf16x8 qr[4];
  #pragma unroll
  for(int d0=0;d0<4;++d0)qr[d0]=*reinterpret_cast<const bf16x8*>(&Qw[(long)r32*DM+d0*16+hi*8]);
  typedef unsigned u32x2_t __attribute__((ext_vector_type(2)));
  typedef __attribute__((address_space(3))) const u32x2_t* lds_ct;
  const lds_ct ctab=(lds_ct)(shm3+LDS_CUM);
  float cq; { const u32x2_t e=ctab[q0+wid*QBLK+r32]; cq=-((__uint_as_float(e[0]<<16)+__uint_as_float(e[0]&0xffff0000u))+__uint_as_float(e[1]<<16)); }
  float mhat=0.f,l_reg=0.f;f32x16 o[2];o[0]=f32x16{};o[1]=f32x16{};
  u32x4 qx;
  const unsigned one2=hi?0u:0x3F803F80u;
  #define SETQX(S_) do{ const float s_=(S_); const unsigned w_=cvtpk_s(s_,0.f); const float r1_=s_-__uint_as_float(w_<<16); const unsigned w2_=cvtpk_s(r1_,0.f); const float r2_=r1_-__uint_as_float(w2_<<16); \
      qx[0]=one2; qx[1]=hi?0u:(0x3F80u|(w_<<16)); qx[2]=hi?0u:((w2_&0xffffu)|(cvtpk_s(r2_,0.f)<<16)); qx[3]=0u; asm volatile("":"+v"(qx)); }while(0)
  SETQX(cq);
  const int ctoff=hi?SEQ:r32;
  #define KXF(T_,H_) ({ const u32x2_t e_=ctab[hi?SEQ:(64*(T_)+32*(H_)+r32)]; u32x4 k_; k_[0]=e_[0]; k_[1]=e_[1]; k_[2]=one2; k_[3]=0u; __builtin_bit_cast(bf16x8,k_); })
  u32x2_t kxa,kxb;
  #define KXLOAD(T_) do{ kxa=ctab[hi?SEQ:(64*(T_)+r32)]; kxb=ctab[hi?SEQ:(64*(T_)+32+r32)]; }while(0)
  #define BIASP(C0,C1) do{ const f32x16 z_=f32x16{}; const bf16x8 qxb_=__builtin_bit_cast(bf16x8,qx); u32x4 ka_,kb_; ka_[0]=kxa[0]; ka_[1]=kxa[1]; ka_[2]=one2; ka_[3]=0u; kb_[0]=kxb[0]; kb_[1]=kxb[1]; kb_[2]=one2; kb_[3]=0u; \
      C0=__builtin_amdgcn_mfma_f32_32x32x16_bf16(__builtin_bit_cast(bf16x8,ka_),qxb_,z_,0,0,0); C1=__builtin_amdgcn_mfma_f32_32x32x16_bf16(__builtin_bit_cast(bf16x8,kb_),qxb_,z_,0,0,0); }while(0)
  #define BIAS0(C0,C1,T_) do{ const f32x16 z_=f32x16{}; const bf16x8 qxb_=__builtin_bit_cast(bf16x8,qx); \
      C0=__builtin_amdgcn_mfma_f32_32x32x16_bf16(KXF(T_,0),qxb_,z_,0,0,0); C1=__builtin_amdgcn_mfma_f32_32x32x16_bf16(KXF(T_,1),qxb_,z_,0,0,0); }while(0)
  const int qrel=wid*QBLK+r32;
  #define CMASK(P0,P1,t) do{int jb_=(t)-(NT-4); if(jb_>=0)cmask(P0,P1,jb_,qrel,hi);}while(0)
  bool resc=false;
  #define START(P0,P1) do{ const float rm=rowmax(P0,P1); resc=false; \
    { const float dl=rm; mhat=fadd_s(mhat,dl); \
      _Pragma("unroll") for(int r=0;r<16;++r){P0[r]=fsub_s(P0[r],dl);P1[r]=fsub_s(P1[r],dl);} \
      SETQX(cq-mhat); } \
    _Pragma("unroll") for(int r=0;r<16;++r)P0[r]=__builtin_amdgcn_exp2f(P0[r]); }while(0)
  #define RESC() do{ if(resc){ asm volatile("s_waitcnt lgkmcnt(0)":::"memory"); \
      _Pragma("unroll") for(int d_=0;d_<2;++d_) _Pragma("unroll") for(int r=0;r<16;++r)o[d_][r]*=wsf[crow(r,hi)]; } }while(0)
  f32x16 pA0,pA1,pB0,pB1;
  int sl_prev=0,sl_cur=0,sl_next=SLOTB;
  #define ROT() do{sl_prev=sl_cur;sl_cur=sl_next;sl_next=(sl_next==(NSLOT-1)*SLOTB)?0:sl_next+SLOTB;}while(0)
  DMA_K(2,2*SLOTB);
  WAIT_BAR(3);
  { f32x16 i0_,i1_; BIAS0(i0_,i1_,TILE(0)); qkt(pA0,pA1,Kbase,qr,i0_,i1_,r32,hi); } asm volatile("s_nop 15\n\ts_nop 7":"+v"(pA0),"+v"(pA1));CMASK(pA0,pA1,0);
  START(pA0,pA1);
  _Pragma("unroll") for(int r=0;r<16;++r)pA1[r]=__builtin_amdgcn_exp2f(pA1[r]);
  WAIT_BAR(0);
  DMA_K(3,0);DMA_V(1,SLOTB);
  ROT();
  kload8(kf,kp0+sl_cur);
  WAIT_BAR(2);
  s16x4 vlo[8],vhi[8]; u32x4 pw0,pw1,pw2,pw3;
  #define PKW(P,B) cvtpk_s(P[B],P[B+1])
  #define PAF(k) __builtin_bit_cast(bf16x8,pw##k)
  #define VFR(i) (bf16x8){vlo[i][0],vlo[i][1],vlo[i][2],vlo[i][3],vhi[i][0],vhi[i][1],vhi[i][2],vhi[i][3]}
  #define PIN(x) asm volatile("":"+v"(x))
  #define MX3(a,b,c) __builtin_fmaxf(__builtin_fmaxf((a),(b)),(c))
  #define GAPA(MF,A0,A1,A2,A3,W0,W1,PW) do{ MF; sacc+=A0; sacc+=A1; sacc+=A2; sacc+=A3; PIN(sacc); W0; W1; PIN(PW); SBAR(); }while(0)
  #define EX(v) __builtin_amdgcn_exp2f(v)
  #define GAPB(MF,X,B) do{ MF; X[B]=EX(X[B]); X[B+1]=EX(X[B+1]); X[B+2]=EX(X[B+2]); X[B+3]=EX(X[B+3]); PIN(X); SBAR(); }while(0)
  #define VRD(i) do{ vlo[i]=vtr(vp_+(((i)>>2)*4096+((i)&3)*1024)); vhi[i]=vtr(vp_+(((i)>>2)*4096+((i)&3)*1024+512)); }while(0)
  #define KRD(G,j) do{ if(G){ kload2(kf,kp0+sl_next,j); SBAR(); } }while(0)
  #define STEP(C0,C1,P0,P1,t,GK,GV,GL) do{ SBAR(); \
    const lds_cptr vp_=vp0+sl_prev; \
    BIASP(C0,C1); KXLOAD(TILE((t)+1)); SBAR(); \
    VRD(0); SBAR(); float sacc=(P0[0]+P0[1]); \
    GAPA(C0=__builtin_amdgcn_mfma_f32_32x32x16_bf16(kf[0],qr[0],C0,0,0,0), P0[2],P0[3],P0[4],P0[5],     pw0[0]=PKW(P0,0), pw0[1]=PKW(P0,2), pw0); \
    VRD(4); SBAR(); GAPA(C1=__builtin_amdgcn_mfma_f32_32x32x16_bf16(kf[1],qr[0],C1,0,0,0), P0[6],P0[7],P0[8],P0[9],     pw0[2]=PKW(P0,4), pw0[3]=PKW(P0,6), pw0); \
    VRD(1); SBAR(); GAPA(C0=__builtin_amdgcn_mfma_f32_32x32x16_bf16(kf[2],qr[1],C0,0,0,0),   P0[10],P0[11],P0[12],P0[13], pw1[0]=PKW(P0,8), pw1[1]=PKW(P0,10), pw1); \
    VRD(5); SBAR(); GAPA(C1=__builtin_amdgcn_mfma_f32_32x32x16_bf16(kf[3],qr[1],C1,0,0,0),   P0[14],P0[15],P1[0],P1[1],   pw1[2]=PKW(P0,12),pw1[3]=PKW(P0,14), pw1); \
    VRD(2); SBAR(); GAPA(C0=__builtin_amdgcn_mfma_f32_32x32x16_bf16(kf[4],qr[2],C0,0,0,0),   P1[2],P1[3],P1[4],P1[5],     pw2[0]=PKW(P1,0), pw2[1]=PKW(P1,2), pw2); \
    VRD(6); SBAR(); GAPA(C1=__builtin_amdgcn_mfma_f32_32x32x16_bf16(kf[5],qr[2],C1,0,0,0),   P1[6],P1[7],P1[8],P1[9],     pw2[2]=PKW(P1,4), pw2[3]=PKW(P1,6), pw2); \
    VRD(3); SBAR(); GAPA(C0=__builtin_amdgcn_mfma_f32_32x32x16_bf16(kf[6],qr[3],C0,0,0,0),   P1[10],P1[11],P1[12],P1[13], pw3[0]=PKW(P1,8), pw3[1]=PKW(P1,10), pw3); \
    VRD(7); SBAR(); GAPA(C1=__builtin_amdgcn_mfma_f32_32x32x16_bf16(kf[7],qr[3],C1,0,0,0),   P1[14],P1[15],0.f,0.f,       pw3[2]=PKW(P1,12),pw3[3]=PKW(P1,14), pw3); \
    l_reg+=sacc; \
    if(GK){DMA_K((t)+3,sl_cur);} if(GV){DMA_V((t)+1,sl_next);} \
    CMASK(C0,C1,t); \
    { float a=MX3(C0[0],C0[1],C1[0]),b=MX3(C0[2],C0[3],C1[1]); a=MX3(a,C1[2],C1[3]); \
      _Pragma("unroll") for(int r=4;r<16;r+=4){a=MX3(a,C0[r],C0[r+1]);b=MX3(b,C0[r+2],C0[r+3]);a=MX3(a,C1[r],C1[r+1]);b=MX3(b,C1[r+2],C1[r+3]);} \
      float rm=__builtin_fmaxf(a,b); { auto rr=__builtin_amdgcn_permlane32_swap(__float_as_uint(rm),__float_as_uint(rm),false,false); rm=__builtin_fmaxf(__uint_as_float(rr[0]),__uint_as_float(rr[1])); } \
      resc=false; \
      if(__builtin_expect(__any(rm>(float)THRL),0)){ const float dl=__builtin_fmaxf(rm,0.f); mhat+=dl; \
        _Pragma("unroll") for(int r=0;r<16;++r){C0[r]-=dl;C1[r]-=dl;} \
        SETQX(cq-mhat); \
        const float f=__builtin_amdgcn_exp2f(-dl); l_reg*=f; if(hi==0)wsf[r32]=f; resc=true; } } \
    SBAR(); \
    GAPB(o[0]=__builtin_amdgcn_mfma_f32_32x32x16_bf16(PAF(0),VFR(0),o[0],0,0,0), C0,0); \
    GAPB(o[1]=__builtin_amdgcn_mfma_f32_32x32x16_bf16(PAF(0),VFR(4),o[1],0,0,0), C0,4); \
    KRD(GL,0); GAPB(o[0]=__builtin_amdgcn_mfma_f32_32x32x16_bf16(PAF(1),VFR(1),o[0],0,0,0), C0,8); \
    KRD(GL,1); GAPB(o[1]=__builtin_amdgcn_mfma_f32_32x32x16_bf16(PAF(1),VFR(5),o[1],0,0,0), C0,12); \
    KRD(GL,2); GAPB(o[0]=__builtin_amdgcn_mfma_f32_32x32x16_bf16(PAF(2),VFR(2),o[0],0,0,0), C1,0); \
    KRD(GL,3); GAPB(o[1]=__builtin_amdgcn_mfma_f32_32x32x16_bf16(PAF(2),VFR(6),o[1],0,0,0), C1,4); \
    GAPB(o[0]=__builtin_amdgcn_mfma_f32_32x32x16_bf16(PAF(3),VFR(3),o[0],0,0,0), C1,8); \
    GAPB(o[1]=__builtin_amdgcn_mfma_f32_32x32x16_bf16(PAF(3),VFR(7),o[1],0,0,0), C1,12); \
    }while(0)
  int t=1; KXLOAD(TILE(1));
  #undef CMASK
  #define CMASK(P0,P1,t) do{}while(0)
  for(;t+5<NT;t+=2){
    STEP(pB0,pB1,pA0,pA1,t,true,true,true);     WAIT_BAR(2); RESC(); ROT();
    STEP(pA0,pA1,pB0,pB1,t+1,true,true,true);   WAIT_BAR(2); RESC(); ROT();
  }
  #undef CMASK
  #define CMASK(P0,P1,t) do{int jb_=(t)-(NT-4); if(jb_>=0)cmask(P0,P1,jb_,qrel,hi);}while(0)
  #define ENDW(tt) do{ if((tt)+3<NT){WAIT_BAR(2);} else if((tt)+2<NT){WAIT_BAR(1);} else {WAIT_BAR(0);} }while(0)
  for(;t+1<NT;t+=2){
    STEP(pB0,pB1,pA0,pA1,t,(t+3<NT),(t+1<NT),(t+1<NT));       ENDW(t);   RESC(); ROT();
    STEP(pA0,pA1,pB0,pB1,t+1,(t+4<NT),(t+2<NT),(t+2<NT));     ENDW(t+1); RESC(); ROT();
  }
  STEP(pB0,pB1,pA0,pA1,NT-1,false,false,false); RESC();
  { float sacc=pB0[0]+pB0[1]; _Pragma("unroll") for(int r=2;r<16;++r)sacc+=pB0[r]; _Pragma("unroll") for(int r=0;r<16;++r)sacc+=pB1[r]; l_reg+=sacc;
    pw0=(u32x4){PKW(pB0,0),PKW(pB0,2),PKW(pB0,4),PKW(pB0,6)};pw1=(u32x4){PKW(pB0,8),PKW(pB0,10),PKW(pB0,12),PKW(pB0,14)};pw2=(u32x4){PKW(pB1,0),PKW(pB1,2),PKW(pB1,4),PKW(pB1,6)};pw3=(u32x4){PKW(pB1,8),PKW(pB1,10),PKW(pB1,12),PKW(pB1,14)};
    SBAR(); pv(o,vb0+sl_cur,PAF(0),PAF(1),PAF(2),PAF(3)); }
  #undef PKW
  #undef PAF
  #undef VFR
  #undef PIN
  #undef MX3
  #undef GAPA
  #undef GAPB
  #undef EX
  #undef VRD
  #undef KRD
  #undef STEP
  #undef ENDW
  {auto rr=__builtin_amdgcn_permlane32_swap(__float_as_uint(l_reg),__float_as_uint(l_reg),false,false);l_reg=__uint_as_float(rr[0])+__uint_as_float(rr[1]);}
  if(hi==0)wsf[32+r32]=l_reg;asm volatile("s_waitcnt lgkmcnt(0)":::"memory");
  float rli[16];
  #pragma unroll
  for(int r=0;r<16;++r)rli[r]=__builtin_amdgcn_rcpf(wsf[32+crow(r,hi)]);
  bf16*Ow=O+(rowbase+q0+wid*QBLK)*OPITCH+h*D;
  { bf16*stg=(bf16*)(shm+LDS_OST)+wid*2048;
    #pragma unroll
    for(int r=0;r<16;++r){const int orow=crow(r,hi);
      #pragma unroll
      for(int d0=0;d0<2;++d0)stg[orow*64+d0*32+r32]=__float2bfloat16(o[d0][r]*rli[r]);}
    asm volatile("s_waitcnt lgkmcnt(0)":::"memory");
    #pragma unroll
    for(int i=0;i<4;++i){const int row=i*8+(lane>>3),ch=lane&7; const u32x4 v=*(const u32x4*)(stg+row*64+ch*8); ATTN_STORE16(Ow+(long)row*OPITCH+ch*8,v);} }
  asm volatile("s_waitcnt lgkmcnt(0)\n\ts_barrier":::"memory");
  #undef DMA_K
  #undef DMA_V
  #undef SETQX
  #undef KXF
  #undef BIAS0
  #undef BIASP
  #undef KXLOAD
  #undef TILE
  #undef CMASK
  #undef START
  #undef RESC
  #undef ROT
}
constexpr int ATTN_LDS_BYTES=LDS_BYTES;
struct AttnTensors { const bf16* Q; const bf16* K; const bf16* V; bf16* O; };
struct AttnUnit { int bh; int qb; };
struct StaticOrder {
  int vcu;
  __device__ __forceinline__ explicit StaticOrder(int grid,int block):vcu((block%8)*(grid/8)+block/8){}
  __device__ __forceinline__ bool next(int i,AttnUnit&u)const{ if(i>=2)return false; const int s=vcu&7; u.bh=vcu>>3; u.qb=(i==0)?s:15-s; return true; }
  __device__ __forceinline__ void a_ready(const AttnUnit&)const{}
  __device__ __forceinline__ void done(const AttnUnit&)const{}
};
struct NoMid{ __device__ __forceinline__ void operator()()const{} };
template<class Sched,int THRL=8,class Mid=NoMid> __device__ __forceinline__ void attn_phase(char*lds,const AttnTensors&T,const float*lft,const Sched&S,const Mid&mid=Mid()){
  AttnUnit u;
  if(!S.next(0,u))return;
  __syncthreads();
  { int tid_=threadIdx.x; asm volatile("":"+v"(tid_)); const int tid=tid_,lane=tid&63,wid=tid>>6; typedef float f32x4_t __attribute__((ext_vector_type(4)));
    const float*src=lft+(long)u.bh*SEQ+tid*8; const f32x4_t a=*(const f32x4_t*)src,b=*(const f32x4_t*)(src+4);
    float v[8]={a[0],a[1],a[2],a[3],b[0],b[1],b[2],b[3]};
    #pragma unroll
    for(int j=1;j<8;++j)v[j]+=v[j-1];
    float sc=v[7];
    #pragma unroll
    for(int o=1;o<64;o<<=1){const float t=__shfl_up(sc,o);if(lane>=o)sc+=t;}
    __attribute__((address_space(3))) float*wsum=(__attribute__((address_space(3))) float*)(lds+LDS_WS);
    typedef unsigned u32x2_t __attribute__((ext_vector_type(2)));
    __attribute__((address_space(3))) u32x2_t*ct=(__attribute__((address_space(3))) u32x2_t*)(lds+LDS_CUM);
    if(lane==63)wsum[wid]=sc;
    __syncthreads();
    float off=sc-v[7];
    for(int w=0;w<wid;++w)off+=wsum[w];
    #pragma unroll
    for(int j=0;j<8;++j){ const float c=(off+v[j])*1.4426950408889634f; const float hf=__uint_as_float(cvtpk_s(c,0.f)<<16), r1=c-hf, mf=__uint_as_float(cvtpk_s(r1,0.f)<<16), r2=r1-mf;
      u32x2_t e; e[0]=cvtpk_s(-hf,-mf); e[1]=cvtpk_s(-r2,1.0f); ct[tid*8+j]=e; }
    if(tid==0){ unsigned zz=0u; asm volatile("":"+v"(zz)); u32x2_t z; z[0]=zz; z[1]=zz; ct[SEQ]=z; }
    __syncthreads(); }
  for(int i=0;S.next(i,u);++i){ if(i==1)mid(); S.a_ready(u); attn_unit<THRL>(u.bh/NHEAD,u.bh%NHEAD,u.qb,T.Q,T.K,T.V,T.O,lds); S.done(u); }
}
#undef SBAR
#undef WAIT_BAR
}
namespace ret {
typedef short bf16x8 __attribute__((ext_vector_type(8)));
typedef short s16x4 __attribute__((ext_vector_type(4)));
typedef float f32x16 __attribute__((ext_vector_type(16)));
typedef float f32x4 __attribute__((ext_vector_type(4)));
typedef unsigned u32x4 __attribute__((ext_vector_type(4)));
typedef unsigned u32x2 __attribute__((ext_vector_type(2)));
typedef LAS const char* lds_cptr;
constexpr int CH = 128;
__device__ __forceinline__ int offb(int row, int ch) { return 256 * row + 16 * (ch ^ (((row & 3) << 2) | ((row >> 2) & 3))); }
__device__ __forceinline__ s16x4 vtr(lds_cptr p) { return __builtin_bit_cast(s16x4, __builtin_amdgcn_ds_read_tr16_b64_v4i16((LAS s16x4*)p)); }
__device__ __forceinline__ bf16x8 tr_frag(lds_cptr img, int Ra, int Rb, int C0blk, int lane) {
    const int q = (lane & 15) >> 2, p = lane & 3, c = ((C0blk + 16 * ((lane >> 4) & 1)) >> 3) + (p >> 1), hb = 8 * (p & 1);
    const s16x4 lo = vtr(img + offb(Ra + q, c) + hb), hi = vtr(img + offb(Rb + q, c) + hb);
    return (bf16x8){lo[0], lo[1], lo[2], lo[3], hi[0], hi[1], hi[2], hi[3]};
}
__device__ __forceinline__ unsigned cvt_pk(float lo, float hi) { unsigned r; asm volatile("v_cvt_pk_bf16_f32 %0, %1, %2" : "=v"(r) : "v"(lo), "v"(hi)); return r; }
__device__ __forceinline__ float lo16(unsigned w) { return __uint_as_float(w << 16); }
__device__ __forceinline__ float hi16(unsigned w) { return __uint_as_float(w & 0xffff0000u); }
__device__ __forceinline__ void store_wt16(bf16_t* p, unsigned v) { asm volatile("global_store_short %0, %1, off sc1" :: "v"(p), "v"(v) : "memory"); }
__device__ __forceinline__ void store_wt32u(unsigned* p, unsigned v) { asm volatile("global_store_dword %0, %1, off sc1" :: "v"(p), "v"(v) : "memory"); }
__device__ __forceinline__ void store_wt32(float* p, float v) { asm volatile("global_store_dword %0, %1, off sc1" :: "v"(p), "v"(v) : "memory"); }
__device__ __forceinline__ int crow(int r, int hi) { return (r & 3) + 8 * (r >> 2) + 4 * hi; }
__device__ __forceinline__ float log2_gamma(int h) { asm volatile("" : "+v"(h)); return log2f(1.f - exp2f(-5.f - (float)h)); }

template <bool SCALE> __device__ __forceinline__ void stage_bf16(LAS char* img, const bf16_t* src, int ld, int tid, float l2g) {
#pragma unroll
    for (int i = 0; i < 4; ++i) { const int c = tid + 512 * i, row = c >> 4, ch = c & 15;
        u32x4 v = *(const u32x4*)(src + (size_t)row * ld + ch * 8);
        if (SCALE) { const float z = exp2f(l2g * (float)(127 - row));
            v.x = cvt_pk(lo16(v.x) * z, hi16(v.x) * z); v.y = cvt_pk(lo16(v.y) * z, hi16(v.y) * z); v.z = cvt_pk(lo16(v.z) * z, hi16(v.z) * z); v.w = cvt_pk(lo16(v.w) * z, hi16(v.w) * z); }
        *(LAS u32x4*)(img + offb(row, ch)) = v; }
}
__device__ __forceinline__ void stage_f32(LAS char* img, const float* src, int tid) {
#pragma unroll
    for (int i = 0; i < 4; ++i) { const int c = tid + 512 * i, row = c >> 4, ch = c & 15;
        const f32x4 a = *(const f32x4*)(src + row * 128 + ch * 8), b = *(const f32x4*)(src + row * 128 + ch * 8 + 4);
        u32x4 v; v.x = cvt_pk(a[0], a[1]); v.y = cvt_pk(a[2], a[3]); v.z = cvt_pk(b[0], b[1]); v.w = cvt_pk(b[2], b[3]);
        *(LAS u32x4*)(img + offb(row, ch)) = v; }
}

__device__ __forceinline__ void stage_ld_bf16(u32x4 (&v)[4], const bf16_t* src, int ld, int tid) {
#pragma unroll
    for (int i = 0; i < 4; ++i) { const int c = tid + 512 * i, row = c >> 4, ch = c & 15; v[i] = *(const u32x4*)(src + (size_t)row * ld + ch * 8); }
}
template <bool SCALE> __device__ __forceinline__ void stage_wr_bf16(LAS char* img, u32x4 (&v)[4], int tid, float l2g) {
#pragma unroll
    for (int i = 0; i < 4; ++i) { const int c = tid + 512 * i, row = c >> 4, ch = c & 15;
        if (SCALE) { const float z = exp2f(l2g * (float)(127 - row));
            v[i].x = cvt_pk(lo16(v[i].x) * z, hi16(v[i].x) * z); v[i].y = cvt_pk(lo16(v[i].y) * z, hi16(v[i].y) * z); v[i].z = cvt_pk(lo16(v[i].z) * z, hi16(v[i].z) * z); v[i].w = cvt_pk(lo16(v[i].w) * z, hi16(v[i].w) * z); }
        *(LAS u32x4*)(img + offb(row, ch)) = v[i]; }
}
__device__ __forceinline__ void stage_ld_f32(f32x4 (&v)[8], const float* src, int tid) {
#pragma unroll
    for (int i = 0; i < 4; ++i) { const int c = tid + 512 * i, row = c >> 4, ch = c & 15; v[2 * i] = *(const f32x4*)(src + row * 128 + ch * 8); v[2 * i + 1] = *(const f32x4*)(src + row * 128 + ch * 8 + 4); }
}
__device__ __forceinline__ void stage_wr_f32(LAS char* img, const f32x4 (&v)[8], int tid) {
#pragma unroll
    for (int i = 0; i < 4; ++i) { const int c = tid + 512 * i, row = c >> 4, ch = c & 15;
        u32x4 w; w.x = cvt_pk(v[2 * i][0], v[2 * i][1]); w.y = cvt_pk(v[2 * i][2], v[2 * i][3]); w.z = cvt_pk(v[2 * i + 1][0], v[2 * i + 1][1]); w.w = cvt_pk(v[2 * i + 1][2], v[2 * i + 1][3]);
        *(LAS u32x4*)(img + offb(row, ch)) = w; }
}

template <int NU> __device__ __forceinline__ void retkv_units(int id0, int idstep, const bf16_t* KR, const bf16_t* VR, bf16_t* KVS, LAS char* lds) {
    int tid_ = threadIdx.x; asm volatile("" : "+v"(tid_));
    const int tid = tid_, lane = tid & 63, wid = __builtin_amdgcn_readfirstlane(tid >> 6), hi = lane >> 5;
    __syncthreads();
    u32x4 kv_[NU][4], vv_[NU][4];
#pragma unroll
    for (int u = 0; u < NU; ++u) { const int id = id0 + u * idstep, bh = id >> 5, n = id & 31, b = bh >> 2, h = bh & 3;
        const size_t rowbase = (size_t)(b * SEQ + n * CH) * 512 + h * 128;
        stage_ld_bf16(kv_[u], KR + rowbase, 512, tid); stage_ld_bf16(vv_[u], VR + rowbase, 512, tid); }
#pragma unroll
    for (int u = 0; u < NU; ++u) { const int id = id0 + u * idstep, h = (id >> 5) & 3;
        stage_wr_bf16<true>(lds + u * 65536, kv_[u], tid, log2_gamma(h)); stage_wr_bf16<false>(lds + u * 65536 + 32768, vv_[u], tid, 0.f); }
    __syncthreads();
    const int mb = wid >> 1, nb0 = 2 * (wid & 1);
#pragma unroll
    for (int u = 0; u < NU; ++u) {
        const lds_cptr Kimg = lds + u * 65536, Vimg = Kimg + 32768;
        f32x16 acc0 = {}, acc1 = {};
#pragma unroll
        for (int s = 0; s < 8; ++s) {
            const int Ra = 16 * s + 8 * hi;
            const bf16x8 A = tr_frag(Kimg, Ra, Ra + 4, 32 * mb, lane);
            const bf16x8 B0 = tr_frag(Vimg, Ra, Ra + 4, 32 * nb0, lane), B1 = tr_frag(Vimg, Ra, Ra + 4, 32 * nb0 + 32, lane);
            acc0 = __builtin_amdgcn_mfma_f32_32x32x16_bf16(A, B0, acc0, 0, 0, 0);
            acc1 = __builtin_amdgcn_mfma_f32_32x32x16_bf16(A, B1, acc1, 0, 0, 0);
        }
        bf16_t* out = KVS + (size_t)(id0 + u * idstep) * 16384 + 32 * nb0 + (lane & 31);
#pragma unroll
        for (int r = 0; r < 16; ++r) { const int dk = 32 * mb + crow(r, hi);
            const float n0 = __shfl_xor(acc0[r], 1), n1 = __shfl_xor(acc1[r], 1);
            if (!(lane & 1)) { store_wt32u((unsigned*)(out + dk * 128), cvt_pk(acc0[r], n0)); store_wt32u((unsigned*)(out + dk * 128 + 32), cvt_pk(acc1[r], n1)); } }
    }
}

__device__ __forceinline__ void ret_scan_pair(unsigned* KVS32, int bh, int q) {
    const float gc = exp2f(128.f * log2_gamma(bh & 3));
    unsigned* p = KVS32 + (size_t)bh * 32 * 8192 + q; float p0 = 0.f, p1 = 0.f; unsigned t[32];
#pragma unroll
    for (int j = 0; j < 32; ++j) t[j] = p[(size_t)j * 8192];
    asm volatile("s_waitcnt vmcnt(0)" : "+v"(t[0]), "+v"(t[1]), "+v"(t[2]), "+v"(t[3]), "+v"(t[4]), "+v"(t[5]), "+v"(t[6]), "+v"(t[7]), "+v"(t[8]), "+v"(t[9]), "+v"(t[10]), "+v"(t[11]), "+v"(t[12]), "+v"(t[13]), "+v"(t[14]), "+v"(t[15]) :: "memory");
    asm volatile("s_waitcnt vmcnt(0)" : "+v"(t[16]), "+v"(t[17]), "+v"(t[18]), "+v"(t[19]), "+v"(t[20]), "+v"(t[21]), "+v"(t[22]), "+v"(t[23]), "+v"(t[24]), "+v"(t[25]), "+v"(t[26]), "+v"(t[27]), "+v"(t[28]), "+v"(t[29]), "+v"(t[30]), "+v"(t[31]) :: "memory");
#pragma unroll
    for (int j = 0; j < 32; ++j) { store_wt32u(p + (size_t)j * 8192, cvt_pk(p0, p1)); p0 = gc * p0 + lo16(t[j]); p1 = gc * p1 + hi16(t[j]); }
}
__device__ __forceinline__ void ret_scan(bf16_t* KVS, int gtid, int nthreads) {
    for (int idx = gtid; idx < 16 * 8192; idx += nthreads) ret_scan_pair((unsigned*)KVS, idx >> 13, idx & 8191);
}
__device__ __forceinline__ void ret_scan_slice(bf16_t* KVS, int bh, int c16, int tid) {
    ret_scan_pair((unsigned*)KVS, bh, c16 * 512 + tid);
}

__device__ __forceinline__ void retout_unit(int bh, int cp, const bf16_t* QR, bf16_t* RO, const bf16_t* KR, const bf16_t* VR, const bf16_t* GR, const bf16_t* KVS, const float* retnorm, LAS char* lds) {
    int tid_ = threadIdx.x; asm volatile("" : "+v"(tid_));
    const int tid = tid_, lane = tid & 63, wid = __builtin_amdgcn_readfirstlane(tid >> 6), hi = lane >> 5, r32 = lane & 31;
    const int b = bh >> 2, h = bh & 3; const float l2g = log2_gamma(h);
    const int c = wid >> 2, qb = wid & 3, n = 2 * cp + c;
    const size_t chunk0 = (size_t)(b * SEQ + n * CH);
    const size_t qoff = (chunk0 + 32 * qb + r32) * 512 + h * 128;
    bf16x8 qf[8]; u32x2 gt[4][4];
#pragma unroll
    for (int s = 0; s < 8; ++s) qf[s] = *(const bf16x8*)(QR + qoff + 16 * s + 8 * hi);
#pragma unroll
    for (int t = 0; t < 4; ++t)
#pragma unroll
        for (int g = 0; g < 4; ++g) gt[t][g] = *(const u32x2*)(GR + qoff + 32 * t + 8 * g + 4 * hi);
    const bf16_t* kp0 = KR + (chunk0 + r32) * 512 + h * 128 + 8 * hi;
    bf16x8 kf[8];
#pragma unroll
    for (int s = 0; s < 8; ++s) kf[s] = *(const bf16x8*)(kp0 + 16 * s);
    asm volatile("s_waitcnt lgkmcnt(0)\n\ts_barrier" ::: "memory");
    { u32x4 vv_[2][4], sv_[2][4];
#pragma unroll
      for (int cc = 0; cc < 2; ++cc) { const int nn = 2 * cp + cc;
          stage_ld_bf16(vv_[cc], VR + (size_t)(b * SEQ + nn * CH) * 512 + h * 128, 512, tid); stage_ld_bf16(sv_[cc], KVS + ((size_t)bh * 32 + nn) * 16384, 128, tid); }
#pragma unroll
      for (int cc = 0; cc < 2; ++cc) { stage_wr_bf16<false>(lds + cc * 65536, vv_[cc], tid, 0.f); stage_wr_bf16<false>(lds + cc * 65536 + 32768, sv_[cc], tid, 0.f); } }
    __syncthreads();
    const lds_cptr Vimg = lds + c * 65536, Simg = Vimg + 32768;
    f32x16 o[4];
#pragma unroll
    for (int t = 0; t < 4; ++t) { o[t] = f32x16{};
#pragma unroll
        for (int s = 0; s < 8; ++s) { const int Ra = 16 * s + 8 * hi; o[t] = __builtin_amdgcn_mfma_f32_32x32x16_bf16(tr_frag(Simg, Ra, Ra + 4, 32 * t, lane), qf[s], o[t], 0, 0, 0); } }
    { const float xi = exp2f(l2g * (float)(32 * qb + r32 + 1));
#pragma unroll
      for (int t = 0; t < 4; ++t)
#pragma unroll
          for (int r = 0; r < 16; ++r) o[t][r] *= xi; }
    for (int jb = 0; jb <= qb; ++jb) {
        f32x16 p = {};
        bf16x8 kn[8];
        const bf16_t* kpn = kp0 + (size_t)(jb < qb ? 32 * (jb + 1) : 0) * 512;
#pragma unroll
        for (int s = 0; s < 8; ++s) kn[s] = *(const bf16x8*)(kpn + 16 * s);
#pragma unroll
        for (int s = 0; s < 8; ++s) p = __builtin_amdgcn_mfma_f32_32x32x16_bf16(kf[s], qf[s], p, 0, 0, 0);
        const int dij = 32 * (qb - jb) + r32;
#pragma unroll
        for (int r = 0; r < 16; ++r) { const int d = dij - crow(r, hi); p[r] = d >= 0 ? p[r] * exp2f(l2g * (float)d) : 0.f; }
        u32x4 w0, w1; w0.x = cvt_pk(p[0], p[1]); w0.y = cvt_pk(p[2], p[3]); w0.z = cvt_pk(p[4], p[5]); w0.w = cvt_pk(p[6], p[7]);
        w1.x = cvt_pk(p[8], p[9]); w1.y = cvt_pk(p[10], p[11]); w1.z = cvt_pk(p[12], p[13]); w1.w = cvt_pk(p[14], p[15]);
        const bf16x8 pb0 = __builtin_bit_cast(bf16x8, w0), pb1 = __builtin_bit_cast(bf16x8, w1);
#pragma unroll
        for (int t = 0; t < 4; ++t) {
            const int R0 = 32 * jb + 4 * hi;
            o[t] = __builtin_amdgcn_mfma_f32_32x32x16_bf16(tr_frag(Vimg, R0, R0 + 8, 32 * t, lane), pb0, o[t], 0, 0, 0);
            o[t] = __builtin_amdgcn_mfma_f32_32x32x16_bf16(tr_frag(Vimg, R0 + 16, R0 + 24, 32 * t, lane), pb1, o[t], 0, 0, 0);
        }
#pragma unroll
        for (int s = 0; s < 8; ++s) kf[s] = kn[s];
    }
    f32x4 rn[4][4];
    { const GAS float* rnp = (const GAS float*)retnorm + h * 128 + 4 * hi; asm volatile("" : "+v"(rnp));
#pragma unroll
      for (int t = 0; t < 4; ++t)
#pragma unroll
          for (int g = 0; g < 4; ++g) rn[t][g] = *(const GAS f32x4*)(rnp + 32 * t + 8 * g); }
    float ss = 0.f;
#pragma unroll
    for (int t = 0; t < 4; ++t)
#pragma unroll
        for (int r = 0; r < 16; ++r) ss += o[t][r] * o[t][r];
    ss += __shfl_xor(ss, 32);
    const float rms = rsqrtf(ss * (1.f / 128.f) + 1e-6f);
#pragma unroll
    for (int t = 0; t < 4; ++t)
#pragma unroll
        for (int g = 0; g < 4; ++g) { const int dv0 = 32 * t + 8 * g + 4 * hi;
            u32x2 w; w.x = cvt_pk(lo16(gt[t][g].x) * o[t][4 * g] * rms * rn[t][g][0], hi16(gt[t][g].x) * o[t][4 * g + 1] * rms * rn[t][g][1]);
            w.y = cvt_pk(lo16(gt[t][g].y) * o[t][4 * g + 2] * rms * rn[t][g][2], hi16(gt[t][g].y) * o[t][4 * g + 3] * rms * rn[t][g][3]);
            *(u32x2*)(RO + (chunk0 + 32 * qb + r32) * 1024 + h * 128 + dv0) = w; }
}
}
#define XB_TMO      128
#define XB_XCNT(j)  (256  + 64 * (j))
#define XB_XSUB(j)  (1280 + 64 * (j))
#define XB_XGEN(j)  (2304 + 64 * (j))
#define XB_TOP      3328
#define XB_TOPGEN   3392
#define XCD_BAR_WORDS 3456
#define XB_SPIN_CAP (1u << 18)

__device__ __forceinline__ unsigned xb_ld(unsigned* p)              { return __hip_atomic_load(p, __ATOMIC_RELAXED, __HIP_MEMORY_SCOPE_AGENT); }
__device__ __forceinline__ unsigned xb_add(unsigned* p, unsigned v) { return __hip_atomic_fetch_add(p, v, __ATOMIC_RELAXED, __HIP_MEMORY_SCOPE_AGENT); }
__device__ __forceinline__ unsigned xb_xcc_id() { return (unsigned)__builtin_amdgcn_s_getreg((3 << 11) | 20) & 0xFu; }
#define XB_SPIN(cond, bar) do { unsigned _sp = 0; while (cond) { __builtin_amdgcn_s_sleep(1); \
    if ((++_sp & 255u) == 0u) { if (xb_ld(&(bar)[XB_TMO])) break; if (_sp > XB_SPIN_CAP) { atomicAdd(&(bar)[XB_TMO], 1u); break; } } } } while (0)

struct XcdBarrier {
    unsigned* bar; unsigned x;
    volatile LAS unsigned* st;
};

__device__ __forceinline__ XcdBarrier xcd_barrier_post(unsigned* bar, volatile LAS unsigned* st) {
    XcdBarrier b; b.bar = bar; b.x = xb_xcc_id(); b.st = st;
    if (threadIdx.x == 0) (void)xb_add(&bar[XB_XCNT(b.x)], 1u);
    return b;
}
__device__ __forceinline__ void xcd_barrier_complete(unsigned* bar, unsigned x, unsigned& nloc, unsigned& nx) {
    const unsigned G = gridDim.x * gridDim.y * gridDim.z;
    unsigned sum, cnt, mine, sp = 0u;
    for (;;) {
        sum = 0u; cnt = 0u; mine = 0u;
#pragma unroll
        for (unsigned j = 0; j < 16; ++j) { const unsigned c = xb_ld(&bar[XB_XCNT(j)]); sum += c; cnt += (c > 0u) ? 1u : 0u; mine = (j == x) ? c : mine; }
        if (sum == G) break;
        __builtin_amdgcn_s_sleep(1);
        if ((++sp & 255u) == 0u) { if (xb_ld(&bar[XB_TMO])) break; if (sp > XB_SPIN_CAP) { atomicAdd(&bar[XB_TMO], 1u); break; } }
    }
    nloc = mine > 0u ? mine : 1u; nx = cnt > 0u ? cnt : 1u;
}

__device__ __forceinline__ void xcd_barrier(const XcdBarrier& b) {
    asm volatile("s_waitcnt vmcnt(0)" ::: "memory");
    __syncthreads();
    if (threadIdx.x == 0) {
        unsigned* bar = b.bar;
        __builtin_amdgcn_s_waitcnt(0);
        unsigned nloc = b.st[0], nx = b.st[1];
        if (nloc == 0u) { xcd_barrier_complete(bar, b.x, nloc, nx); b.st[0] = nloc; b.st[1] = nx; }
        const unsigned old = xb_add(&bar[XB_XSUB(b.x)], 1u);
        const unsigned gen = old / nloc;
        if (old + 1u == (gen + 1u) * nloc) {
            __builtin_amdgcn_fence(__ATOMIC_RELEASE, "agent");
            asm volatile("s_waitcnt vmcnt(0)" ::: "memory");
            const unsigned og = xb_add(&bar[XB_TOP], 1u);
            const unsigned tg = og / nx;
            if (og + 1u == (tg + 1u) * nx) xb_add(&bar[XB_TOPGEN], 1u);
            else XB_SPIN(xb_ld(&bar[XB_TOPGEN]) == tg, bar);
            __builtin_amdgcn_fence(__ATOMIC_ACQUIRE, "agent");
            xb_add(&bar[XB_XGEN(b.x)], 1u);
            asm volatile("s_waitcnt vmcnt(0)" ::: "memory");
        } else {
            XB_SPIN(xb_ld(&bar[XB_XGEN(b.x)]) == gen, bar);
            __builtin_amdgcn_fence(__ATOMIC_ACQUIRE, "agent");
            asm volatile("s_waitcnt vmcnt(0)" ::: "memory");
        }
    }
    __syncthreads();
}
constexpr int NWAVES = 8;
constexpr int RING_OFF = 0, RING_BYTES = 131072;
constexpr int LDSCTL_OFF = RING_BYTES, MISC_OFF = LDSCTL_OFF + 320;
constexpr int LDS_BYTES = 147456;
typedef GAS unsigned gu32;
typedef unsigned v4u __attribute__((ext_vector_type(4)));
typedef float f32x4 __attribute__((ext_vector_type(4)));
#define LDS_WAIT() asm volatile("s_waitcnt lgkmcnt(0)" ::: "memory")
#define VM_WAIT() asm volatile("s_waitcnt vmcnt(0)" ::: "memory")

struct Args { const float* in[15]; float* out; unsigned char* ws; int ph_lo, ph_hi, li, flags; };
enum { IN_X = 0, IN_NORM1, IN_W1IN, IN_W1OUT, IN_NORMMIX, IN_WIN, IN_BFORGET, IN_RETNORM, IN_WORET, IN_WOFOX, IN_WOUT, IN_NORM2, IN_W2IN, IN_W2OUT, IN_NORMFINAL };

struct Frame {
    LAS unsigned char* lds;
    volatile LAS unsigned* MISC;
    int wave, vcu, G;
};
__device__ __forceinline__ int tid_now() { int t = threadIdx.x; asm volatile("" : "+v"(t)); return t; }

__device__ __forceinline__ void cv_load(const float* W, int ldw, int srccol, int nvalid, const float* gain, int k0, int lane, float (&v)[32], f32x4 (&g)[2]) {
    const int n = lane & 31, nc = n < nvalid ? n : 0;
    int ldw_ = ldw; asm volatile("" : "+s"(ldw_));
    const unsigned voff = (unsigned)((lane >> 5) * ldw_ + nc);
    const float* rp = W + (size_t)k0 * ldw_ + srccol;
#pragma unroll
    for (int i = 0; i < 32; ++i) v[i] = __builtin_nontemporal_load(rp + (size_t)(2 * i) * ldw_ + voff);
    if (gain) { g[0] = *(const f32x4*)(gain + k0 + 8 * (lane & 7)); g[1] = *(const f32x4*)(gain + k0 + 8 * (lane & 7) + 4); }
    if (nvalid < 32) {
#pragma unroll
        for (int i = 0; i < 32; ++i) v[i] = n < nvalid ? v[i] : 0.f; }
}
__device__ __forceinline__ void cv_finish(float (&v)[32], const float* gain, const f32x4 (&g)[2], int Kp, bf16_t* WT, int drow0, int kd0, LAS float* scr, int lane) {
    const int n = lane & 31;
#pragma unroll
    for (int i = 0; i < 32; ++i) scr[(2 * i + (lane >> 5)) * 33 + n] = v[i];
    LDS_WAIT(); asm volatile("" ::: "memory");
    const int c = lane & 7;
#pragma unroll
    for (int j = 0; j < 4; ++j) { const int nn = (lane >> 3) + 8 * j; const LAS float* s = scr + (8 * c) * 33 + nn;
        f32x4 a = (f32x4){s[0 * 33], s[1 * 33], s[2 * 33], s[3 * 33]}, b = (f32x4){s[4 * 33], s[5 * 33], s[6 * 33], s[7 * 33]};
        if (gain) { a *= g[0]; b *= g[1]; }
        v4u o; o.x = pk2(a[0], a[1]); o.y = pk2(a[2], a[3]); o.z = pk2(b[0], b[1]); o.w = pk2(b[2], b[3]);
        __builtin_nontemporal_store(o, (GAS v4u*)(WT + (size_t)(drow0 + nn) * Kp + kd0 + 8 * c)); }
    LDS_WAIT(); asm volatile("" ::: "memory");
}
__device__ __forceinline__ int src_col32(int kind, int rho0, int& nvalid) {
    nvalid = 32;
    if (kind == 0) return rho0;
    const int pn = rho0 >> 8, bj = (rho0 >> 7) & 1, j = rho0 & 127;
    if (kind == 1) return (bj ? DFF : 0) + 128 * pn + j;
    if (pn < 4) return (pn < 2 ? C_RQ : C_RK) + (2 * (pn & 1) + (j >> 6)) * 128 + 64 * bj + (j & 63);
    if (pn < 14) return rho0;
    if (pn < 22) return (bj ? C_GF : C_GR) + 128 * (pn - 14) + j;
    nvalid = (rho0 == 22 * 256) ? 8 : 0; return C_FF;
}
constexpr int CI_1IN = (D / 64) * (2 * DFF / 32), CI_1OUT = (DFF / 64) * (D / 32), CI_IN = (D / 64) * (NIN / 32), CI_O = (512 / 64) * (D / 32), CI_OUT = (D / 64) * (D / 32);
constexpr int CI_LAYER = 2 * CI_1IN + 2 * CI_1OUT + CI_IN + 2 * CI_O + CI_OUT;
__device__ __forceinline__ void convert_mat(const float* W, int ldw, const float* gain, int K, int Kp, int koff, bf16_t* WT, int N, int kind, int off, int lo, int hi, int w, int nw, LAS float* scr, int lane) {
    const int nblk = N / 32, nitems = (K / 64) * nblk;
    int a = lo > off ? lo : off; const int b = hi < off + nitems ? hi : off + nitems;
    if (a >= b) return;
    { int r = (a - lo - w) % nw; if (r < 0) r += nw; if (r) a += nw - r; }
    for (int fi = a; fi < b; fi += nw) { const int it = fi - off, kb = it / nblk, nb = it % nblk; int nvalid; const int sc = src_col32(kind, 32 * nb, nvalid);
        float v[32]; f32x4 g[2]; cv_load(W, ldw, sc, nvalid, gain, 64 * kb, lane, v, g); cv_finish(v, gain, g, Kp, WT, 32 * nb, koff + 64 * kb, scr, lane); }
}
__device__ __forceinline__ void convert_layer_range(const float* const* in, unsigned char* ws, int l, int lo, int hi, int w, int nw, LAS float* scr, int lane) {
    unsigned char* wl = ws + WS_W + (size_t)l * W_LAYER; int off = 0;
    convert_mat(in[IN_W1IN] + (size_t)l * D * 2 * DFF, 2 * DFF, in[IN_NORM1] + l * D, D, D, 0, (bf16_t*)(wl + WO_1IN), 2 * DFF, 1, off, lo, hi, w, nw, scr, lane); off += CI_1IN;
    convert_mat(in[IN_W1OUT] + (size_t)l * DFF * D, D, nullptr, DFF, DFF, 0, (bf16_t*)(wl + WO_1OUT), D, 0, off, lo, hi, w, nw, scr, lane); off += CI_1OUT;
    convert_mat(in[IN_WIN] + (size_t)l * D * IN_COLS, IN_COLS, in[IN_NORMMIX] + l * D, D, D, 0, (bf16_t*)(wl + WO_IN), NIN, 2, off, lo, hi, w, nw, scr, lane); off += CI_IN;
    convert_mat(in[IN_WORET] + (size_t)l * 512 * D, D, nullptr, 512, 1024, 0, (bf16_t*)(wl + WO_OR), D, 0, off, lo, hi, w, nw, scr, lane); off += CI_O;
    convert_mat(in[IN_WOFOX] + (size_t)l * 512 * D, D, nullptr, 512, 1024, 512, (bf16_t*)(wl + WO_OR), D, 0, off, lo, hi, w, nw, scr, lane); off += CI_O;
    convert_mat(in[IN_WOUT] + (size_t)l * D * D, D, nullptr, D, D, 0, (bf16_t*)(wl + WO_OUT), D, 0, off, lo, hi, w, nw, scr, lane); off += CI_OUT;
    convert_mat(in[IN_W2IN] + (size_t)l * D * 2 * DFF, 2 * DFF, in[IN_NORM2] + l * D, D, D, 0, (bf16_t*)(wl + WO_2IN), 2 * DFF, 1, off, lo, hi, w, nw, scr, lane); off += CI_1IN;
    convert_mat(in[IN_W2OUT] + (size_t)l * DFF * D, D, nullptr, DFF, DFF, 0, (bf16_t*)(wl + WO_2OUT), D, 0, off, lo, hi, w, nw, scr, lane);
}
constexpr int CG_PRO = 5120, CG_A = 5120, CG_C = 2176;
static_assert(CI_LAYER == 12416 && CG_PRO + DEPTH * (2 * CG_A + CG_C) >= DEPTH * CI_LAYER, "conversion slots cover the list");
__device__ __forceinline__ void convert_global_range(const float* const* in, unsigned char* ws, int lo, int hi, int w, int nw, LAS float* scr, int lane) {
    if (hi > DEPTH * CI_LAYER) hi = DEPTH * CI_LAYER;
    for (int l = lo / CI_LAYER; l < DEPTH && l * CI_LAYER < hi; ++l) {
        const int a = lo - l * CI_LAYER, b = hi - l * CI_LAYER;
        convert_layer_range(in, ws, l, a > 0 ? a : 0, b < CI_LAYER ? b : CI_LAYER, w, nw, scr, lane);
    }
}
__device__ __forceinline__ int slot_start(int l, int which) { return CG_PRO + l * (2 * CG_A + CG_C) + (which == 0 ? 0 : which == 1 ? CG_A : CG_A + CG_C); }

#define NREP(bit) ((PROBE_DUP & (bit)) ? 2 : 1)
#ifndef PROBE_PHSEL
#define PROBE_PHSEL 0x7ff
#endif
#ifndef PROBE_BLOCK
#define PROBE_BLOCK 0
#endif
constexpr size_t WS_DUMMY = WS_END;
constexpr int PH_PER_LAYER = 10, PH_FINAL = 1 + DEPTH * PH_PER_LAYER, N_PHASES = PH_FINAL + 1;
__global__ void __launch_bounds__(NWAVES * 64, 2) mega(Args args) {
    extern __shared__ __attribute__((aligned(16))) unsigned char lds[];
    Frame F;
    F.lds = (LAS unsigned char*)lds;
    F.MISC = (volatile LAS unsigned*)(F.lds + MISC_OFF);
    F.wave = __builtin_amdgcn_readfirstlane((int)threadIdx.x >> 6);
    F.G = gridDim.x; { const int bx = blockIdx.x; F.vcu = (F.G % 8 == 0) ? (bx % 8) * (F.G / 8) + bx / 8 : bx; }
    unsigned char* ws = args.ws;
    gu32* ctl = (gu32*)(ws + WS_CTL);
    for (int u = threadIdx.x; u < (LDS_BYTES - LDSCTL_OFF) / 4; u += NWAVES * 64) ((LAS unsigned*)(F.lds + LDSCTL_OFF))[u] = 0u;
    __syncthreads();
    XcdBarrier bar = xcd_barrier_post((unsigned*)(ctl + CW_BAR) + args.li * XCD_BAR_WORDS, F.MISC + 8);
    const int lo = args.ph_lo, hi = args.ph_hi;
#define IN(k) (lo <= (k) && (k) < hi)
    if (PROBE_SPIN && threadIdx.x == 0) { F.MISC[16] = 0u; F.MISC[17] = (unsigned)__builtin_amdgcn_s_memrealtime(); }
#define SEAM(k) do { if (IN(k) && IN((k) + 1)) { unsigned t0_ = 0; if (PROBE_SPIN == 1) t0_ = (unsigned)__builtin_amdgcn_s_memrealtime(); xcd_barrier(bar); if (PROBE_DUP & 256) xcd_barrier(bar); \
        if (PROBE_SPIN && threadIdx.x == 0) { const unsigned t1_ = (unsigned)__builtin_amdgcn_s_memrealtime(); const int slot_ = (k) == 0 ? 10 : ((k) - 1) % PH_PER_LAYER; \
            if ((PROBE_PHSEL >> slot_) & 1) F.MISC[16] = F.MISC[16] + (PROBE_SPIN == 1 ? t1_ - t0_ : t1_ - F.MISC[17]); F.MISC[17] = t1_; } } } while (0)
    unsigned gseq = 0u;
#define GROUP_SEAM(k) do { if (IN(k) && IN((k) + 1)) { if (F.G == 256) { gseq += 4u; gu32* gc_ = ctl + CW_GRP + 64 * (8 * ((int)blockIdx.x & 7) + (((int)blockIdx.x >> 3) & 7)); \
            VM_WAIT(); __syncthreads(); \
            if (threadIdx.x == 0) { __hip_atomic_fetch_add(gc_, 1u, __ATOMIC_RELAXED, __HIP_MEMORY_SCOPE_AGENT); \
                for (unsigned sp_ = 0; __hip_atomic_load(gc_, __ATOMIC_RELAXED, __HIP_MEMORY_SCOPE_AGENT) < gseq && sp_ < (1u << 22); ++sp_) __builtin_amdgcn_s_sleep(1); \
                __builtin_amdgcn_fence(__ATOMIC_ACQUIRE, "agent"); VM_WAIT(); } \
            __syncthreads(); } else xcd_barrier(bar); } } while (0)
    float* x = args.out;
    float* part = (float*)(ws + WS_PART);
    bf16_t* XB = (bf16_t*)(ws + WS_XB); bf16_t* HB = (bf16_t*)(ws + WS_H);
    bf16_t* RF = (bf16_t*)((unsigned char*)args.out + 32 * MiB);
    const int gw = F.vcu * NWAVES + F.wave, NGW = F.G * NWAVES;

    if (IN(0)) for (int rep_ = 0; rep_ < NREP(128); ++rep_) {
        const int lane = tid_now() & 63;
        LAS float* scr = (LAS float*)(F.lds + RING_OFF + F.wave * 16384);
        convert_global_range(args.in, ws, 0, CG_PRO, gw, NGW, scr, lane);
        {
            float* cs = (float*)(ws + WS_COS); float* sn = (float*)(ws + WS_SIN);
            for (int idx = gw * 64 + lane; idx < SEQ * 64; idx += NGW * 64) { const int s = idx >> 6, i = idx & 63;
                const float inv = exp2f(-0.20762050593046014f * (float)i);
                const double rev = (double)s * (double)inv * 0.15915494309189535;
                const float fr = (float)(rev - floor(rev)); cs[idx] = __builtin_amdgcn_cosf(fr); sn[idx] = __builtin_amdgcn_sinf(fr); }
        }
        const float* xin = args.in[IN_X];
        for (int m0 = gw; m0 < M; m0 += 4 * NGW) {
            f32x4 v[4][4];
#pragma unroll
            for (int q = 0; q < 4; ++q) { const int m = m0 + q * NGW; if (m < M) { const GAS f32x4* xr = (const GAS f32x4*)(xin + (size_t)m * D) + lane;
#pragma unroll
                for (int j = 0; j < 4; ++j) v[q][j] = xr[64 * j]; } }
#pragma unroll
            for (int q = 0; q < 4; ++q) { const int m = m0 + q * NGW; if (m < M) { float s = 0.f;
#pragma unroll
                for (int j = 0; j < 4; ++j) { const unsigned w0 = pk2(v[q][j][0], v[q][j][1]), w1 = pk2(v[q][j][2], v[q][j][3]);
                    const float a0 = __uint_as_float(w0 << 16), a1 = __uint_as_float(w0 & 0xffff0000u), a2 = __uint_as_float(w1 << 16), a3 = __uint_as_float(w1 & 0xffff0000u); s += (a0 * a0 + a1 * a1) + (a2 * a2 + a3 * a3);
                    ((GAS unsigned long long*)(XB + (size_t)m * D))[lane + 64 * j] = (unsigned long long)w0 | ((unsigned long long)w1 << 32); }
                s = wave_sum(s);
                if (lane < 16) part[(size_t)m * 16 + lane] = lane == 0 ? s : 0.f; } }
        }
    }
    SEAM(0);

    for (int hl = 0; hl < 2 * DEPTH; ++hl) {
        const int l = hl >> 1, odd = hl & 1, pb = 1 + l * PH_PER_LAYER;
        unsigned char* wl = ws + WS_W + (size_t)l * W_LAYER;
        if (odd) {
        if (IN(pb + 2)) {
            pg8::Gemm g{XB, (const bf16_t*)(wl + WO_IN), M, NIN, D}; pg8::StaticOrder S; S.init(M, NIN, F.G, (int)blockIdx.x);
            pg8::RstdTab rt{part, (const LAS float*)(F.lds + LDSCTL_OFF + 1024), -1}; { pg8::Unit u0{0, 0}; (void)S.next(0, u0); rt.pm0 = u0.pm; pg8::rstd_fill(part, u0.pm, (LAS float*)(F.lds + LDSCTL_OFF + 1024), tid_now()); }
            pg8::EpiInproj E{rt, (const float*)(ws + WS_COS), (const float*)(ws + WS_SIN), args.in[IN_BFORGET] + l * FH, ws, (float*)(ws + WS_LFT)};
            pg8::gemm_phase<pg8::EpiInproj, pg8::StaticOrder, true, true>(F.lds + RING_OFF, g, S, E);
            if ((int)blockIdx.x >= 192) convert_global_range(args.in, ws, slot_start(l, 1), slot_start(l, 1) + CG_C, ((int)blockIdx.x - 192) * NWAVES + F.wave, 64 * NWAVES, (LAS float*)(F.lds + RING_OFF + F.wave * 16384), tid_now() & 63);
        }
        SEAM(pb + 2);
        if (IN(pb + 3)) {
#define BH_POST(which) do { VM_WAIT(); __syncthreads(); if (threadIdx.x == 0) __hip_atomic_fetch_add(ctl + CW_GRP + 64 * (64 + 2 * bh_ + (which)), 1u, __ATOMIC_RELAXED, __HIP_MEMORY_SCOPE_AGENT); } while (0)
#define BH_POLL(which) do { if (threadIdx.x == 0) { gu32* gc_ = ctl + CW_GRP + 64 * (64 + 2 * bh_ + (which)); const unsigned want_ = 16u * (unsigned)(l + 1); \
                        for (unsigned sp_ = 0; __hip_atomic_load(gc_, __ATOMIC_RELAXED, __HIP_MEMORY_SCOPE_AGENT) < want_ && sp_ < (1u << 22); ++sp_) __builtin_amdgcn_s_sleep(1); \
                        __builtin_amdgcn_fence(__ATOMIC_ACQUIRE, "agent"); VM_WAIT(); } \
                    __syncthreads(); } while (0)
#if !(PROBE_DUP & 24)
            {
                const int bh_ = F.vcu >> 4, c_ = F.vcu & 15;
                ret::retkv_units<2>(bh_ * 32 + 2 * c_, 1, (const bf16_t*)(ws + WS_KR), (const bf16_t*)(ws + WS_VR), (bf16_t*)x, (LAS char*)(F.lds + RING_OFF));
                BH_POST(0);
                { const fox::AttnTensors AT{(const fox::bf16*)(ws + WS_FQ), (const fox::bf16*)(ws + WS_FK), (const fox::bf16*)(ws + WS_FV), (fox::bf16*)(RF + 512)};
                  unsigned pa0_ = 0; if (PROBE_SPIN == 5) pa0_ = (unsigned)__builtin_amdgcn_s_memrealtime();
                  const fox::StaticOrder S((int)F.G, (int)blockIdx.x);
                  auto mid = [&]() { BH_POLL(0); ret::ret_scan_slice((bf16_t*)x, bh_, c_, tid_now()); BH_POST(1); };
                  fox::attn_phase<fox::StaticOrder, 8>((char*)lds + RING_OFF, AT, (const float*)(ws + WS_LFT), S, mid);
                  if (PROBE_SPIN == 5 && threadIdx.x == 0) F.MISC[16] = F.MISC[16] + ((unsigned)__builtin_amdgcn_s_memrealtime() - pa0_); }
                BH_POLL(1);
                ret::retout_unit(bh_, c_, (const bf16_t*)(ws + WS_QR), RF, (const bf16_t*)(ws + WS_KR), (const bf16_t*)(ws + WS_VR), (const bf16_t*)(ws + WS_GR), (const bf16_t*)x, args.in[IN_RETNORM] + l * 512, (LAS char*)(F.lds + RING_OFF));
            }
#else
            {
            if (args.flags & 2) {
              if (F.G == 256) {
                const int bh_ = F.vcu >> 4, c_ = F.vcu & 15;
                ret::retkv_units<2>(bh_ * 32 + 2 * c_, 1, (const bf16_t*)(ws + WS_KR), (const bf16_t*)(ws + WS_VR), (bf16_t*)x, (LAS char*)(F.lds + RING_OFF));
                BH_POST(0); BH_POLL(0);
                ret::ret_scan_slice((bf16_t*)x, bh_, c_, tid_now());
                BH_POST(1); BH_POLL(1);
              } else {
                ret::retkv_units<2>(F.vcu, 256, (const bf16_t*)(ws + WS_KR), (const bf16_t*)(ws + WS_VR), (bf16_t*)x, (LAS char*)(F.lds + RING_OFF));
                xcd_barrier(bar);
                ret::ret_scan((bf16_t*)x, F.vcu * (NWAVES * 64) + tid_now(), F.G * NWAVES * 64);
                xcd_barrier(bar);
              }
                for (int rep_ = NREP(16) - 1; rep_ >= 0; --rep_) for (int id = F.vcu; id < 256; id += F.G) ret::retout_unit(id >> 4, id & 15, (const bf16_t*)(ws + WS_QR), rep_ ? (bf16_t*)(ws + WS_DUMMY) : RF, (const bf16_t*)(ws + WS_KR), (const bf16_t*)(ws + WS_VR), (const bf16_t*)(ws + WS_GR),
                                                                                            (const bf16_t*)x, args.in[IN_RETNORM] + l * 512, (LAS char*)(F.lds + RING_OFF)); }
            if (args.flags & 1) for (int rep_ = NREP(8) - 1; rep_ >= 0; --rep_) { const fox::AttnTensors AT{(const fox::bf16*)(ws + WS_FQ), (const fox::bf16*)(ws + WS_FK), (const fox::bf16*)(ws + WS_FV), (fox::bf16*)(rep_ ? (bf16_t*)(ws + WS_DUMMY) : RF + 512)};
                const fox::StaticOrder S((int)F.G, (int)blockIdx.x); fox::attn_phase<fox::StaticOrder>((char*)lds + RING_OFF, AT, (const float*)(ws + WS_LFT), S); }
            }
#endif
#undef BH_POST
#undef BH_POLL
        }
        SEAM(pb + 3);
        if (IN(pb + 6)) {
            pg8::Gemm g{RF, (const bf16_t*)(wl + WO_OR), M, D, D}; pg8::StaticOrder S; S.init(M, D, F.G, (int)blockIdx.x);
            pg8::EpiGated E{(const bf16_t*)(ws + WS_GATER), (const bf16_t*)(ws + WS_GATEF), (bf16_t*)(ws + WS_MERGED)};
            for (int rep_ = 0; rep_ < NREP(32); ++rep_) pg8::gemm_phase<pg8::EpiGated, pg8::StaticOrder, true, true>(F.lds + RING_OFF, g, S, E);
        }
        GROUP_SEAM(pb + 6);
        if (IN(pb + 7)) {
            pg8::Gemm g{(const bf16_t*)(ws + WS_MERGED), (const bf16_t*)(wl + WO_OUT), M, D, D}; pg8::StaticOrder S; S.init(M, D, F.G, (int)blockIdx.x);
            { pg8::EpiResid E{XB, part, 1.f, 1.f}; pg8::gemm_phase<pg8::EpiResid, pg8::StaticOrder, true, true>(F.lds + RING_OFF, g, S, E); }
        }
        SEAM(pb + 7);
        }
        const int kin = pb + (odd ? 8 : 0), kout = kin + 1;
        if (IN(kin)) { pg8::Gemm g{XB, (const bf16_t*)(wl + (odd ? WO_2IN : WO_1IN)), M, 2 * DFF, D}; pg8::StaticOrder S; S.init(M, 2 * DFF, F.G, (int)blockIdx.x);
            pg8::RstdTab rt{part, (const LAS float*)(F.lds + LDSCTL_OFF + 1024), -1}; { pg8::Unit u0{0, 0}; (void)S.next(0, u0); rt.pm0 = u0.pm; pg8::rstd_fill(part, u0.pm, (LAS float*)(F.lds + LDSCTL_OFF + 1024), tid_now()); }
            pg8::EpiSwiglu E{HB, rt}; pg8::gemm_phase<pg8::EpiSwiglu, pg8::StaticOrder, true, true>(F.lds + RING_OFF, g, S, E);
            if ((int)blockIdx.x >= 128) convert_global_range(args.in, ws, slot_start(l, odd ? 2 : 0), slot_start(l, odd ? 2 : 0) + CG_A, ((int)blockIdx.x - 128) * NWAVES + F.wave, 128 * NWAVES, (LAS float*)(F.lds + RING_OFF + F.wave * 16384), tid_now() & 63); }
        GROUP_SEAM(kin);
        if (IN(kout)) { pg8::Gemm g{HB, (const bf16_t*)(wl + (odd ? WO_2OUT : WO_1OUT)), M, D, DFF}; pg8::StaticOrder S; S.init(M, D, F.G, (int)blockIdx.x);
            { pg8::EpiResid E{XB, part, 0.5f, 2.f}; pg8::gemm_phase<pg8::EpiResid, pg8::StaticOrder, true, true>(F.lds + RING_OFF, g, S, E); } }
        SEAM(kout);
    }
    if (IN(PH_FINAL)) {
        const float* g = args.in[IN_NORMFINAL]; const int lane = tid_now() & 63;
        f32x4 gg[4];
#pragma unroll
        for (int j = 0; j < 4; ++j) gg[j] = ((const GAS f32x4*)g)[lane + 64 * j];
        for (int m0 = gw; m0 < M; m0 += 4 * NGW) {
            float ps[4]; unsigned long long w[4][4];
#pragma unroll
            for (int q = 0; q < 4; ++q) { const int m = m0 + q * NGW; if (m < M) { ps[q] = lane < 16 ? part[(size_t)m * 16 + lane] : 0.f;
#pragma unroll
                for (int j = 0; j < 4; ++j) w[q][j] = ((const GAS unsigned long long*)(XB + (size_t)m * D))[lane + 64 * j]; } }
#pragma unroll
            for (int q = 0; q < 4; ++q) { const int m = m0 + q * NGW; if (m < M) {
                const float rstd = rsqrtf(wave_sum(ps[q]) * (1.f / D) + EPS);
                GAS f32x4* xr = (GAS f32x4*)(x + (size_t)m * D) + lane;
#pragma unroll
                for (int j = 0; j < 4; ++j) { const unsigned w0 = (unsigned)w[q][j], w1 = (unsigned)(w[q][j] >> 32);
                    const f32x4 v = (f32x4){__uint_as_float(w0 << 16), __uint_as_float(w0 & 0xffff0000u), __uint_as_float(w1 << 16), __uint_as_float(w1 & 0xffff0000u)}; xr[64 * j] = v * rstd * gg[j]; } } }
        }
    }
    if (PROBE_SPIN && blockIdx.x == PROBE_BLOCK && threadIdx.x == 0) { const unsigned long long te = __builtin_amdgcn_s_memrealtime(), w = 8ull * F.MISC[16]; while (__builtin_amdgcn_s_memrealtime() - te < w) __builtin_amdgcn_s_sleep(8); }
#undef IN
#undef SEAM
}
#ifndef SLOW_MIXER
#define SLOW_MIXER 0
#endif
extern "C" void kernel_launch(void* const* d_in, const int* in_sizes, int n_in, void* d_out, int out_size, void* d_ws, size_t ws_size, hipStream_t stream) {
    static int grid = 0;
    if (grid == 0) {
        if (n_in != 15 || out_size != M * D || ws_size < WS_END + (PROBE_DUP ? 32 * MiB : 0)) { fprintf(stderr, "kernel_launch: unexpected shapes (n_in %d out %d ws %zu, need %zu)\n", n_in, out_size, ws_size, (size_t)WS_END); grid = -1; return; }
        int dev = 0, cus = 0, per_cu = 0;
        if (hipGetDevice(&dev) != hipSuccess || hipDeviceGetAttribute(&cus, hipDeviceAttributeMultiprocessorCount, dev) != hipSuccess) { grid = -1; return; }
        if (hipFuncSetAttribute((const void*)mega, hipFuncAttributeMaxDynamicSharedMemorySize, LDS_BYTES) != hipSuccess) { fprintf(stderr, "kernel_launch: hipFuncSetAttribute failed\n"); grid = -1; return; }
        if (hipOccupancyMaxActiveBlocksPerMultiprocessor(&per_cu, (const void*)mega, NWAVES * 64, LDS_BYTES) != hipSuccess || per_cu < 1) { fprintf(stderr, "kernel_launch: occupancy query says %d\n", per_cu); }
        (void)hipGetLastError();
        grid = cus;
        if (grid != 256) { fprintf(stderr, "kernel_launch: built for a 256-CU device (the attention / retention unit deals assume 256 workgroups), found %d\n", cus); grid = -1; return; }
    }
    if (grid < 0) return;
    unsigned char* ws = (unsigned char*)d_ws;
    (void)hipMemsetAsync(ws + WS_CTL, 0, CTL_BYTES, stream);
    Args a{};
    for (int i = 0; i < 15; ++i) a.in[i] = (const float*)d_in[i];
    a.out = (float*)d_out; a.ws = ws;
    int li = 0;
#define LAUNCH(lo_, hi_) do { a.ph_lo = (lo_); a.ph_hi = (hi_); a.li = li++; hipLaunchKernelGGL(mega, dim3(grid), dim3(NWAVES * 64), LDS_BYTES, stream, a); } while (0)
#if 0
#else
    a.flags = 3;
    LAUNCH(0, N_PHASES);
#endif
}
```
